# Optimizing an MI355X kernel written in HIP

```python
import math
import jax, jax.numpy as jnp
from jax import lax
import numpy as np

D_MODEL = 1024
BATCH = 2
SEQ = 8192
DEPTH = 2

HEAD_DIM = 64
BLOCK = 128
A_Q_HEADS = 6
A_KV_HEADS = 2
WINDOW = 128
A_WIDTH = A_Q_HEADS * HEAD_DIM
A_KV_WIDTH = A_KV_HEADS * HEAD_DIM
B_HEADS = 4
B_WIDTH = B_HEADS * HEAD_DIM
DECAY_RANK = 64
ICLR_RANK = 64
GATE_RANK = 128
GN_EPS = 64e-5
C_HEADS = 6
C_WIDTH = C_HEADS * HEAD_DIM
MIX_WIDTH = A_WIDTH + B_WIDTH + C_WIDTH
A_COLS = A_WIDTH + 2 * A_KV_WIDTH
B_COLS = 3 * B_WIDTH + DECAY_RANK + ICLR_RANK + GATE_RANK
C_COLS = 3 * C_WIDTH
IN_COLS = A_COLS + B_COLS + C_COLS
NUM_BUCKETS = 32
MAX_EXACT = NUM_BUCKETS // 2
MAX_DISTANCE = 128
N_EXPERTS = 16
N_GROUPS = 4
EXPERTS_PER_GROUP = N_EXPERTS // N_GROUPS
TOP_K = 2
D_FF_EXPERT = 256
LN_EPS = 1e-5
ALPHA = (2 * DEPTH) ** 0.25
BETA_INIT = (8 * DEPTH) ** -0.25

kernel_name = "hybrid_swa_rwkv7_stickbreak_grouped_moe"


def layer_norm(x, g, b):
    xf = x.astype(jnp.float32)
    mu = xf.mean(-1, keepdims=True)
    var = jnp.square(xf - mu).mean(-1, keepdims=True)
    return ((xf - mu) * lax.rsqrt(var + LN_EPS) * g + b).astype(x.dtype)


def t5_causal_bucket(dist):
    dist = jnp.maximum(dist, 0)
    d = jnp.maximum(dist, 1).astype(jnp.float32)
    large = MAX_EXACT + (jnp.log(d / MAX_EXACT) / math.log(MAX_DISTANCE / MAX_EXACT)
                         * (NUM_BUCKETS - MAX_EXACT)).astype(jnp.int32)
    large = jnp.minimum(large, NUM_BUCKETS - 1)
    return jnp.where(dist < MAX_EXACT, dist, large)


def swa_sink_attention(q, k, v, sinks, rel_bias):
    B_, S, Hq, Dh = q.shape
    nb = S // BLOCK
    grp = Hq // A_KV_HEADS
    f32 = jnp.float32
    qb = q.astype(f32).reshape(B_, nb, BLOCK, A_KV_HEADS, grp, Dh)
    pad = ((0, 0), (BLOCK, 0), (0, 0), (0, 0))
    kb = jnp.pad(k.astype(f32), pad).reshape(B_, nb + 1, BLOCK, A_KV_HEADS, Dh)
    vb = jnp.pad(v.astype(f32), pad).reshape(B_, nb + 1, BLOCK, A_KV_HEADS, Dh)
    kband = jnp.concatenate([kb[:, :-1], kb[:, 1:]], axis=2)
    vband = jnp.concatenate([vb[:, :-1], vb[:, 1:]], axis=2)
    logits = jnp.einsum('bnqhgd,bnkhd->bnhgqk', qb, kband) * (Dh ** -0.5)
    qi = jnp.arange(BLOCK)[:, None]
    ki = jnp.arange(2 * BLOCK)[None, :]
    dist = qi + BLOCK - ki
    in_window = (dist >= 0) & (dist < WINDOW)
    key_pos = jnp.arange(nb)[:, None, None] * BLOCK - BLOCK + ki[None]
    valid = in_window[None] & (key_pos >= 0)
    bias = rel_bias.astype(f32)[t5_causal_bucket(dist)]
    bias = bias.transpose(2, 0, 1).reshape(A_KV_HEADS, grp, BLOCK, 2 * BLOCK)
    logits = jnp.where(valid[None, :, None, None], logits + bias[None, None], -jnp.inf)
    sink = sinks.astype(f32).reshape(1, 1, A_KV_HEADS, grp, 1, 1)
    m = jnp.maximum(logits.max(-1, keepdims=True), sink)
    p = jnp.exp(logits - m)
    probs = p / (p.sum(-1, keepdims=True) + jnp.exp(sink - m))
    out = jnp.einsum('bnhgqk,bnkhd->bnqhgd', probs, vband)
    return out.reshape(B_, S, Hq * Dh)


def stick_breaking_attention(q, k, v):
    B_, S, H, Dh = q.shape
    nb = S // BLOCK
    f32 = jnp.float32
    qb = q.astype(f32).reshape(B_, nb, BLOCK, H, Dh).transpose(1, 0, 3, 2, 4)
    kt = k.astype(f32).transpose(0, 2, 1, 3)
    vt = v.astype(f32).transpose(0, 2, 1, 3)
    key_pos = jnp.arange(S)
    scale = Dh ** -0.5

    def one_block(args):
        qblk, start = args
        z = jnp.einsum('bhqd,bhkd->bhqk', qblk, kt) * scale
        q_pos = start + jnp.arange(BLOCK)
        before = key_pos[None, :] < q_pos[:, None]
        log_beta = jnp.where(before, jax.nn.log_sigmoid(z), -jnp.inf)
        log_keep = jnp.where(before, jax.nn.log_sigmoid(-z), 0.0)
        suffix = lax.cumsum(log_keep, axis=3, reverse=True) - log_keep
        w = jnp.exp(log_beta + suffix)
        return jnp.einsum('bhqk,bhkd->bhqd', w, vt)

    out = lax.map(one_block, (qb, jnp.arange(nb) * BLOCK))
    return out.transpose(1, 0, 3, 2, 4).reshape(B_, S, H * Dh)


def token_shift_mix(p, mu):
    prev = jnp.pad(p, ((0, 0), (1, 0), (0, 0)))[:, :-1]
    return p + (prev - p) * mu


def rwkv7_scan(r, w, k, v, a, b):
    B_, S, H, N = r.shape

    def step(state, inp):
        r_t, w_t, k_t, v_t, a_t, b_t = inp
        sa = jnp.einsum('bhvk,bhk->bhv', state, a_t)
        state = (state * w_t[:, :, None, :] + sa[..., None] * b_t[:, :, None, :]
                 + v_t[..., None] * k_t[:, :, None, :])
        return state, jnp.einsum('bhvk,bhk->bhv', state, r_t)

    xs = tuple(t.transpose(1, 0, 2, 3) for t in (r, w, k, v, a, b))
    _, ys = lax.scan(step, jnp.zeros((B_, H, N, N), jnp.float32), xs)
    return ys.transpose(1, 0, 2, 3)


def rwkv7_time_mix(p, shift_mu, decay_w0, decay_up, iclr_a0, iclr_up, gate_up,
                   k_k, k_a, r_k, lnx_g, lnx_b):
    f32 = jnp.float32
    B_, S, _ = p.shape
    p = token_shift_mix(p, shift_mu)
    cuts = [B_WIDTH, 2 * B_WIDTH, 3 * B_WIDTH, 3 * B_WIDTH + DECAY_RANK,
            3 * B_WIDTH + DECAY_RANK + ICLR_RANK]
    r, k, v, xw, xa, xg = jnp.split(p, cuts, axis=-1)
    log_decay = -jax.nn.softplus(-(decay_w0 + jnp.tanh(xw) @ decay_up).astype(f32)) - 0.5
    decay = jnp.exp(-jnp.exp(log_decay))
    a = jax.nn.sigmoid((iclr_a0 + xa @ iclr_up).astype(f32))
    g = (jax.nn.sigmoid(xg) @ gate_up).astype(f32)
    heads = lambda t: t.astype(f32).reshape(B_, S, B_HEADS, HEAD_DIM)
    r, k, v, a_h, decay_h = heads(r), heads(k), heads(v), heads(a), heads(decay)
    kk = k * k_k.astype(f32).reshape(B_HEADS, HEAD_DIM)
    kk = kk * lax.rsqrt(jnp.maximum(jnp.sum(kk * kk, -1, keepdims=True), 1e-24))
    k = k * (1.0 + (a_h - 1.0) * k_a.astype(f32).reshape(B_HEADS, HEAD_DIM))
    y = rwkv7_scan(r, decay_h, k, v, -kk, kk * a_h)
    mu = y.mean(-1, keepdims=True)
    var = jnp.square(y - mu).mean(-1, keepdims=True)
    y = ((y - mu) * lax.rsqrt(var + GN_EPS)).reshape(B_, S, B_WIDTH) * lnx_g + lnx_b
    bonus = (jnp.sum(r * k * r_k.astype(f32), -1, keepdims=True) * v).reshape(B_, S, B_WIDTH)
    return (y + bonus) * g


def hybrid_mixer(h, w_in, w_out, sinks, rel_bias, shift_mu, decay_w0, decay_up,
                 iclr_a0, iclr_up, gate_up, k_k, k_a, r_k, lnx_g, lnx_b):
    B_, S, _ = h.shape
    proj = h @ w_in
    pa = proj[..., :A_COLS]
    pb = proj[..., A_COLS:A_COLS + B_COLS]
    pc = proj[..., A_COLS + B_COLS:]
    qa = pa[..., :A_WIDTH].reshape(B_, S, A_Q_HEADS, HEAD_DIM)
    ka = pa[..., A_WIDTH:A_WIDTH + A_KV_WIDTH].reshape(B_, S, A_KV_HEADS, HEAD_DIM)
    va = pa[..., A_WIDTH + A_KV_WIDTH:].reshape(B_, S, A_KV_HEADS, HEAD_DIM)
    out_a = swa_sink_attention(qa, ka, va, sinks, rel_bias).astype(h.dtype)
    out_b = rwkv7_time_mix(pb, shift_mu, decay_w0, decay_up, iclr_a0, iclr_up, gate_up,
                           k_k, k_a, r_k, lnx_g, lnx_b).astype(h.dtype)
    qc, kc, vc = [t.reshape(B_, S, C_HEADS, HEAD_DIM) for t in jnp.split(pc, 3, axis=-1)]
    out_c = stick_breaking_attention(qc, kc, vc).astype(h.dtype)
    return jnp.concatenate([out_a, out_b, out_c], axis=-1) @ w_out


def grouped_moe(h, router_w, router_bias, w_gate, w_up, w_down):
    B_, S, D = h.shape
    xt = h.reshape(-1, D)
    scores = jax.nn.sigmoid((xt @ router_w).astype(jnp.float32))
    sel = scores + router_bias.astype(jnp.float32)
    group_score = lax.top_k(sel.reshape(-1, N_GROUPS, EXPERTS_PER_GROUP), TOP_K)[0].sum(-1)
    best_group = jnp.argmax(group_score, axis=-1)
    in_group = jnp.repeat(jax.nn.one_hot(best_group, N_GROUPS, dtype=jnp.bool_),
                          EXPERTS_PER_GROUP, axis=1)
    _, top_idx = lax.top_k(jnp.where(in_group, sel, -jnp.inf), TOP_K)
    top_w = jnp.take_along_axis(scores, top_idx, axis=-1)
    top_w = top_w / top_w.sum(-1, keepdims=True)
    gates = (jax.nn.one_hot(top_idx, N_EXPERTS, dtype=jnp.float32) * top_w[..., None]).sum(1)
    hg = jnp.einsum('nd,edf->enf', xt, w_gate)
    hu = jnp.einsum('nd,edf->enf', xt, w_up)
    act = jax.nn.silu(hg) * hu * gates.T[:, :, None].astype(hg.dtype)
    y = jnp.einsum('enf,efd->nd', act, w_down)
    return y.reshape(B_, S, D).astype(h.dtype)


def setup_inputs(seed: int = 0) -> dict:
    key = jax.random.key(seed)
    ks = iter(jax.random.split(key, 40))
    f32 = jnp.float32
    L = DEPTH
    nrm = lambda shape, s: jax.random.normal(next(ks), shape, f32) * s
    uni = lambda shape, lo, hi: jax.random.uniform(next(ks), shape, f32, lo, hi)
    return {
        "x": nrm((BATCH, SEQ, D_MODEL), 1.0),
        "ln0_g": 1.0 + nrm((D_MODEL,), 0.02),
        "ln0_b": nrm((D_MODEL,), 0.02),
        "w_in": nrm((L, D_MODEL, IN_COLS), D_MODEL ** -0.5),
        "w_out": nrm((L, MIX_WIDTH, D_MODEL), MIX_WIDTH ** -0.5 * BETA_INIT),
        "sinks": nrm((L, A_Q_HEADS), 0.5),
        "rel_bias": nrm((NUM_BUCKETS, A_Q_HEADS), 0.5),
        "shift_mu": uni((L, B_COLS), 0.0, 1.0),
        "decay_w0": uni((L, B_WIDTH), -6.0, -1.0),
        "decay_up": nrm((L, DECAY_RANK, B_WIDTH), 0.5 * DECAY_RANK ** -0.5),
        "iclr_a0": nrm((L, B_WIDTH), 0.1),
        "iclr_up": nrm((L, ICLR_RANK, B_WIDTH), ICLR_RANK ** -0.5),
        "gate_up": nrm((L, GATE_RANK, B_WIDTH), GATE_RANK ** -0.5),
        "k_k": 0.85 + nrm((L, B_WIDTH), 0.05),
        "k_a": 1.0 + nrm((L, B_WIDTH), 0.05),
        "r_k": nrm((L, B_HEADS, HEAD_DIM), 0.1),
        "lnx_g": 1.0 + nrm((L, B_WIDTH), 0.02),
        "lnx_b": nrm((L, B_WIDTH), 0.02),
        "ln1_g": 1.0 + nrm((L, D_MODEL), 0.02),
        "ln1_b": nrm((L, D_MODEL), 0.02),
        "router_w": nrm((D_MODEL, N_EXPERTS), D_MODEL ** -0.5),
        "router_bias": nrm((N_EXPERTS,), 0.01),
        "w_gate": nrm((L, N_EXPERTS, D_MODEL, D_FF_EXPERT), D_MODEL ** -0.5),
        "w_up": nrm((L, N_EXPERTS, D_MODEL, D_FF_EXPERT), D_MODEL ** -0.5),
        "w_down": nrm((L, N_EXPERTS, D_FF_EXPERT, D_MODEL), D_FF_EXPERT ** -0.5 * BETA_INIT),
        "ln2_g": 1.0 + nrm((L, D_MODEL), 0.02),
        "ln2_b": nrm((L, D_MODEL), 0.02),
    }


def reference(x, ln0_g, ln0_b, w_in, w_out, sinks, rel_bias, shift_mu, decay_w0, decay_up,
              iclr_a0, iclr_up, gate_up, k_k, k_a, r_k, lnx_g, lnx_b, ln1_g, ln1_b,
              router_w, router_bias, w_gate, w_up, w_down, ln2_g, ln2_b):
    h = layer_norm(x, ln0_g, ln0_b)
    for l in range(DEPTH):
        m = hybrid_mixer(h, w_in[l], w_out[l], sinks[l], rel_bias, shift_mu[l], decay_w0[l],
                         decay_up[l], iclr_a0[l], iclr_up[l], gate_up[l], k_k[l], k_a[l],
                         r_k[l], lnx_g[l], lnx_b[l])
        h = layer_norm(ALPHA * h + m, ln1_g[l], ln1_b[l])
        f = grouped_moe(h, router_w, router_bias, w_gate[l], w_up[l], w_down[l])
        h = layer_norm(ALPHA * h + f, ln2_g[l], ln2_b[l])
    return h
```

```cpp
#include <hip/hip_runtime.h>
#include <stdint.h>

typedef unsigned short bf16_t;
__device__ __forceinline__ bf16_t f2bf(float f) { unsigned u = __float_as_uint(f); u += 0x7FFFu + ((u >> 16) & 1u); return (bf16_t)(u >> 16); }
__device__ __forceinline__ float bf2f(bf16_t b) { return __uint_as_float(((unsigned)b) << 16); }

constexpr int D = 1024, SEQ = 8192, NTOK = 16384, INC = 2816;
constexpr float ALPHA = 1.41421356237f;

__device__ __forceinline__ float wave_sum(float v) {
#pragma unroll
    for (int o = 32; o > 0; o >>= 1) v += __shfl_xor(v, o, 64);
    return v;
}
__device__ __forceinline__ float wave_max(float v) {
#pragma unroll
    for (int o = 32; o > 0; o >>= 1) v = fmaxf(v, __shfl_xor(v, o, 64));
    return v;
}
__device__ __forceinline__ float sigmoidf_(float x) { return 1.0f / (1.0f + __expf(-x)); }

__global__ void __launch_bounds__(256) k_ln(const float* a, const float* c, float alpha,
                                            const float* __restrict__ g, const float* __restrict__ b, float* out) {
    __shared__ float red[8];
    const int t = blockIdx.x, tid = threadIdx.x;
    float v[4]; float s = 0.f;
#pragma unroll
    for (int i = 0; i < 4; ++i) { const int col = tid + 256 * i; float x = alpha * a[(size_t)t * D + col]; if (c) x += c[(size_t)t * D + col]; v[i] = x; s += x; }
    s = wave_sum(s); if ((tid & 63) == 0) red[tid >> 6] = s; __syncthreads();
    const float mu = (red[0] + red[1] + red[2] + red[3]) * (1.0f / D);
    float q = 0.f;
#pragma unroll
    for (int i = 0; i < 4; ++i) { const float d = v[i] - mu; q += d * d; }
    q = wave_sum(q); if ((tid & 63) == 0) red[4 + (tid >> 6)] = q; __syncthreads();
    const float var = (red[4] + red[5] + red[6] + red[7]) * (1.0f / D);
    const float rs = rsqrtf(var + 1e-5f);
#pragma unroll
    for (int i = 0; i < 4; ++i) { const int col = tid + 256 * i; out[(size_t)t * D + col] = (v[i] - mu) * rs * g[col] + b[col]; }
}

template <typename TA> __device__ __forceinline__ float ldA(const TA* p);
template <> __device__ __forceinline__ float ldA<float>(const float* p) { return *p; }
template <> __device__ __forceinline__ float ldA<bf16_t>(const bf16_t* p) { return bf2f(*p); }
__device__ __forceinline__ void stC(float* p, float v) { *p = v; }
__device__ __forceinline__ void stC(bf16_t* p, float v) { *p = f2bf(v); }

template <typename TA, typename TC>
__global__ void __launch_bounds__(256) k_gemm_naive(const TA* __restrict__ A, int lda, const float* __restrict__ W, int ldw, TC* __restrict__ C, int ldc, int K) {
    __shared__ float As[16][65];
    __shared__ float Ws[16][64];
    const int bm = blockIdx.y * 64, bn = blockIdx.x * 64, tid = threadIdx.x, tx = tid & 15, ty = tid >> 4;
    float acc[4][4];
#pragma unroll
    for (int i = 0; i < 4; ++i)
#pragma unroll
        for (int j = 0; j < 4; ++j) acc[i][j] = 0.f;
    for (int k0 = 0; k0 < K; k0 += 16) {
#pragma unroll
        for (int i = 0; i < 4; ++i) { const int idx = tid + i * 256; const int r = idx >> 4, cc = idx & 15; As[cc][r] = ldA<TA>(A + (size_t)(bm + r) * lda + k0 + cc); }
#pragma unroll
        for (int i = 0; i < 4; ++i) { const int idx = tid + i * 256; const int r = idx >> 6, cc = idx & 63; Ws[r][cc] = W[(size_t)(k0 + r) * ldw + bn + cc]; }
        __syncthreads();
#pragma unroll
        for (int kk = 0; kk < 16; ++kk) {
            float av[4], bv[4];
#pragma unroll
            for (int i = 0; i < 4; ++i) av[i] = As[kk][ty * 4 + i];
#pragma unroll
            for (int j = 0; j < 4; ++j) bv[j] = Ws[kk][tx * 4 + j];
#pragma unroll
            for (int i = 0; i < 4; ++i)
#pragma unroll
                for (int j = 0; j < 4; ++j) acc[i][j] += av[i] * bv[j];
        }
        __syncthreads();
    }
#pragma unroll
    for (int i = 0; i < 4; ++i)
#pragma unroll
        for (int j = 0; j < 4; ++j) stC(C + (size_t)(bm + ty * 4 + i) * ldc + bn + tx * 4 + j, acc[i][j]);
}

__device__ __forceinline__ int t5_bucket(int dist) {
    if (dist < 16) return dist;
    int large = 16 + (int)(logf((float)dist * (1.0f / 16.0f)) / 2.0794415416798357f * 16.0f);
    return large < 31 ? large : 31;
}
__global__ void __launch_bounds__(256) k_attn_a(const bf16_t* __restrict__ proj, const float* __restrict__ sinks, const float* __restrict__ rel_bias, bf16_t* __restrict__ mix) {
    const int lane = threadIdx.x & 63, idx = blockIdx.x * 4 + (threadIdx.x >> 6);
    const int t = idx / 6, hq = idx % 6, kv = hq / 3, tl = t & (SEQ - 1);
    const bf16_t* qp = proj + (size_t)t * INC + hq * 64;
    float q[64];
#pragma unroll
    for (int d = 0; d < 64; ++d) q[d] = bf2f(qp[d]);
    float lg[2]; bool val[2];
#pragma unroll
    for (int i = 0; i < 2; ++i) {
        const int dist = lane + 64 * i; val[i] = (tl - dist) >= 0; float dot = 0.f;
        if (val[i]) { const bf16_t* kp = proj + (size_t)(t - dist) * INC + 384 + kv * 64;
#pragma unroll
            for (int d = 0; d < 64; ++d) dot += q[d] * bf2f(kp[d]); }
        lg[i] = val[i] ? dot * 0.125f + rel_bias[t5_bucket(dist) * 6 + hq] : -INFINITY;
    }
    const float sink = sinks[hq];
    const float m = fmaxf(wave_max(fmaxf(lg[0], lg[1])), sink);
    float p[2];
#pragma unroll
    for (int i = 0; i < 2; ++i) p[i] = val[i] ? __expf(lg[i] - m) : 0.f;
    const float denom = wave_sum(p[0] + p[1]) + __expf(sink - m);
    float acc = 0.f;
    for (int dist = 0; dist < 128; ++dist) {
        const float pd = __shfl(dist < 64 ? p[0] : p[1], dist & 63, 64);
        if (tl - dist >= 0) acc += pd * bf2f(proj[(size_t)(t - dist) * INC + 512 + kv * 64 + lane]);
    }
    mix[(size_t)t * D + hq * 64 + lane] = f2bf(acc / denom);
}

__global__ void __launch_bounds__(256) k_attn_c(const bf16_t* __restrict__ proj, bf16_t* __restrict__ mix) {
    const int lane = threadIdx.x & 63, idx = blockIdx.x * 4 + (threadIdx.x >> 6);
    const int t = idx / 6, h = idx % 6, tl = t & (SEQ - 1);
    const bf16_t* qp = proj + (size_t)t * INC + 1664 + h * 64;
    float q[64];
#pragma unroll
    for (int d = 0; d < 64; ++d) q[d] = bf2f(qp[d]);
    float acc = 0.f, carry = 0.f;
    for (int base = 1; base <= tl; base += 64) {
        const int dist = base + lane; const bool valid = dist <= tl;
        float z = 0.f;
        if (valid) { const bf16_t* kp = proj + (size_t)(t - dist) * INC + 1664 + 384 + h * 64;
#pragma unroll
            for (int d = 0; d < 64; ++d) z += q[d] * bf2f(kp[d]); }
        z *= 0.125f;
        const float sp = fmaxf(z, 0.f) + log1pf(__expf(-fabsf(z)));
        const float lk = valid ? -sp : 0.f, lb = z - sp;
        float incl = lk;
#pragma unroll
        for (int o = 1; o < 64; o <<= 1) { const float n = __shfl_up(incl, o, 64); if (lane >= o) incl += n; }
        const float w = valid ? __expf(lb + carry + incl - lk) : 0.f;
        for (int j = 0; j < 64; ++j) {
            const float wj = __shfl(w, j, 64);
            if (base + j <= tl) acc += wj * bf2f(proj[(size_t)(t - base - j) * INC + 1664 + 768 + h * 64 + lane]);
        }
        carry += __shfl(incl, 63, 64);
        if (carry < -60.0f) break;
    }
    mix[(size_t)t * D + 640 + h * 64 + lane] = f2bf(acc);
}

struct RwkvP { const float *shift_mu, *decay_w0, *decay_up, *iclr_a0, *iclr_up, *gate_up, *k_k, *k_a, *r_k, *lnx_g, *lnx_b; };
__global__ void __launch_bounds__(256) k_rwkv_prep(const bf16_t* __restrict__ proj, int tok0, RwkvP P,
                                                   float* __restrict__ R, float* __restrict__ Wd, float* __restrict__ Kk, float* __restrict__ V,
                                                   float* __restrict__ Aa, float* __restrict__ Bb, float* __restrict__ G, float* __restrict__ BON) {
    __shared__ float p[1024];
    const int tl = blockIdx.x, c = threadIdx.x; const size_t t = (size_t)tok0 + tl;
    const bf16_t* pr = proj + t * INC + 640;
#pragma unroll
    for (int i = 0; i < 4; ++i) { const int col = c + 256 * i; const float cur = bf2f(pr[col]); const float prv = tl > 0 ? bf2f(pr[col - INC]) : 0.f; p[col] = cur + (prv - cur) * P.shift_mu[col]; }
    __syncthreads();
    const float r = p[c], k = p[256 + c], v = p[512 + c];
    float u = P.decay_w0[c], a = P.iclr_a0[c], g = 0.f;
    for (int j = 0; j < 64; ++j) { u += tanhf(p[768 + j]) * P.decay_up[j * 256 + c]; a += p[832 + j] * P.iclr_up[j * 256 + c]; }
    for (int j = 0; j < 128; ++j) g += sigmoidf_(p[896 + j]) * P.gate_up[j * 256 + c];
    a = sigmoidf_(a);
    const float w = __expf(-0.6065306597f * sigmoidf_(u));
    const float kk = k * P.k_k[c];
    const float ss = wave_sum(kk * kk);
    const float kkn = kk * rsqrtf(fmaxf(ss, 1e-24f));
    const float kmod = k * (1.0f + (a - 1.0f) * P.k_a[c]);
    const float bon = wave_sum(r * kmod * P.r_k[c]);
    const size_t o = (size_t)tl * 256 + c;
    R[o] = r; Wd[o] = w; Kk[o] = kmod; V[o] = v; Aa[o] = -kkn; Bb[o] = kkn * a; G[o] = g;
    if ((c & 63) == 0) BON[tl * 4 + (c >> 6)] = bon;
}
__global__ void __launch_bounds__(64) k_rwkv_scan(const float* __restrict__ R, const float* __restrict__ Wd, const float* __restrict__ Kk, const float* __restrict__ V,
                                                  const float* __restrict__ Aa, const float* __restrict__ Bb, float* __restrict__ Y) {
    const int h = blockIdx.x, lane = threadIdx.x;
    float S[64];
#pragma unroll
    for (int j = 0; j < 64; ++j) S[j] = 0.f;
    for (int t = 0; t < SEQ; ++t) {
        const size_t o = (size_t)t * 256 + h * 64;
        const float vv = V[o + lane];
        float sa = 0.f;
#pragma unroll
        for (int j = 0; j < 64; ++j) sa += S[j] * Aa[o + j];
        float y = 0.f;
#pragma unroll
        for (int j = 0; j < 64; ++j) { S[j] = S[j] * Wd[o + j] + sa * Bb[o + j] + vv * Kk[o + j]; y += S[j] * R[o + j]; }
        Y[o + lane] = y;
    }
}
__global__ void __launch_bounds__(256) k_rwkv_out(const float* __restrict__ Y, const float* __restrict__ V, const float* __restrict__ G, const float* __restrict__ BON,
                                                  RwkvP P, int tok0, bf16_t* __restrict__ mix) {
    const int tl = blockIdx.x, c = threadIdx.x; const size_t o = (size_t)tl * 256 + c;
    const float y = Y[o];
    const float mu = wave_sum(y) * (1.0f / 64.0f);
    const float d = y - mu;
    const float var = wave_sum(d * d) * (1.0f / 64.0f);
    const float yn = d * rsqrtf(var + 64e-5f) * P.lnx_g[c] + P.lnx_b[c];
    const float out = (yn + BON[tl * 4 + (c >> 6)] * V[o]) * G[o];
    mix[((size_t)tok0 + tl) * D + 384 + c] = f2bf(out);
}

__global__ void __launch_bounds__(256) k_moe_naive(const float* __restrict__ H1, const float* __restrict__ router_w, const float* __restrict__ router_bias,
                                                   const float* __restrict__ w_gate, const float* __restrict__ w_up, const float* __restrict__ w_down, float* __restrict__ F) {
    __shared__ float x[1024]; __shared__ float part[16][16]; __shared__ float sc[16]; __shared__ float act[256];
    __shared__ int sel_e[2]; __shared__ float sel_w[2]; __shared__ float sl[16];
    const int t = blockIdx.x, tid = threadIdx.x;
#pragma unroll
    for (int i = 0; i < 4; ++i) x[tid + 256 * i] = H1[(size_t)t * D + tid + 256 * i];
    __syncthreads();
    { const int e = tid & 15, pt = tid >> 4; float s = 0.f; for (int d = pt * 64; d < pt * 64 + 64; ++d) s += x[d] * router_w[d * 16 + e]; part[pt][e] = s; }
    __syncthreads();
    if (tid < 16) { float s = 0.f; for (int i = 0; i < 16; ++i) s += part[i][tid]; sc[tid] = sigmoidf_(s); sl[tid] = sc[tid] + router_bias[tid]; }
    __syncthreads();
    if (tid == 0) {
        int bg = 0; float bs = -INFINITY;
        for (int g = 0; g < 4; ++g) { float m1 = -INFINITY, m2 = -INFINITY; for (int i = 0; i < 4; ++i) { const float v = sl[g * 4 + i]; if (v > m1) { m2 = m1; m1 = v; } else if (v > m2) m2 = v; }
            const float gs = m1 + m2; if (gs > bs) { bs = gs; bg = g; } }
        int i1 = -1, i2 = -1; float m1 = -INFINITY, m2 = -INFINITY;
        for (int i = 0; i < 4; ++i) { const float v = sl[bg * 4 + i]; if (v > m1) { m2 = m1; i2 = i1; m1 = v; i1 = i; } else if (v > m2) { m2 = v; i2 = i; } }
        const int e1 = bg * 4 + i1, e2 = bg * 4 + i2; const float w1 = sc[e1], w2 = sc[e2], inv = 1.0f / (w1 + w2);
        sel_e[0] = e1; sel_e[1] = e2; sel_w[0] = w1 * inv; sel_w[1] = w2 * inv;
    }
    __syncthreads();
    float y[4] = {0.f, 0.f, 0.f, 0.f};
    for (int s = 0; s < 2; ++s) {
        const int e = sel_e[s]; const float gw = sel_w[s];
        const float* wg = w_gate + (size_t)e * 1024 * 256; const float* wu = w_up + (size_t)e * 1024 * 256; const float* wd = w_down + (size_t)e * 256 * 1024;
        float hg = 0.f, hu = 0.f;
        for (int d = 0; d < 1024; ++d) { const float xv = x[d]; hg += xv * wg[d * 256 + tid]; hu += xv * wu[d * 256 + tid]; }
        __syncthreads();
        act[tid] = hg * sigmoidf_(hg) * hu * gw;
        __syncthreads();
        for (int f = 0; f < 256; ++f) { const float a = act[f];
#pragma unroll
            for (int i = 0; i < 4; ++i) y[i] += a * wd[(size_t)f * 1024 + tid + 256 * i]; }
    }
#pragma unroll
    for (int i = 0; i < 4; ++i) F[(size_t)t * D + tid + 256 * i] = y[i];
}

extern "C" void kernel_launch(void* const* d_in, const int* in_sizes, int n_in, void* d_out, int out_size, void* d_ws, size_t ws_size, hipStream_t stream) {
    const float* x = (const float*)d_in[0];
    const float* ln0_g = (const float*)d_in[1]; const float* ln0_b = (const float*)d_in[2];
    const float* w_in = (const float*)d_in[3]; const float* w_out = (const float*)d_in[4];
    const float* sinks = (const float*)d_in[5]; const float* rel_bias = (const float*)d_in[6];
    const float* shift_mu = (const float*)d_in[7]; const float* decay_w0 = (const float*)d_in[8]; const float* decay_up = (const float*)d_in[9];
    const float* iclr_a0 = (const float*)d_in[10]; const float* iclr_up = (const float*)d_in[11]; const float* gate_up = (const float*)d_in[12];
    const float* k_k = (const float*)d_in[13]; const float* k_a = (const float*)d_in[14]; const float* r_k = (const float*)d_in[15];
    const float* lnx_g = (const float*)d_in[16]; const float* lnx_b = (const float*)d_in[17];
    const float* ln1_g = (const float*)d_in[18]; const float* ln1_b = (const float*)d_in[19];
    const float* router_w = (const float*)d_in[20]; const float* router_bias = (const float*)d_in[21];
    const float* w_gate = (const float*)d_in[22]; const float* w_up = (const float*)d_in[23]; const float* w_down = (const float*)d_in[24];
    const float* ln2_g = (const float*)d_in[25]; const float* ln2_b = (const float*)d_in[26];

    char* ws = (char*)d_ws;
    float* H = (float*)ws;
    bf16_t* PROJ = (bf16_t*)(ws + 67108864);
    float* M1 = (float*)(ws + 67108864);
    bf16_t* MIX = (bf16_t*)(ws + 67108864 + 92274688);
    float* F = (float*)(ws + 67108864 + 92274688);
    float* RW = (float*)(ws + 67108864 + 92274688 + 33554432);
    const size_t RA = (size_t)SEQ * 256;
    float *rR = RW, *rW = RW + RA, *rK = RW + 2 * RA, *rV = RW + 3 * RA, *rA = RW + 4 * RA, *rB = RW + 5 * RA, *rG = RW + 6 * RA, *rBON = RW + 7 * RA;
    float* rY = rA;
    rY = RW + 7 * RA + 65536;

    k_ln<<<NTOK, 256, 0, stream>>>(x, nullptr, 1.0f, ln0_g, ln0_b, H);
    for (int l = 0; l < 2; ++l) {
        k_gemm_naive<float, bf16_t><<<dim3(INC / 64, NTOK / 64), 256, 0, stream>>>(H, D, w_in + (size_t)l * D * INC, INC, PROJ, INC, D);
        k_attn_a<<<NTOK * 6 / 4, 256, 0, stream>>>(PROJ, sinks + l * 6, rel_bias, MIX);
        k_attn_c<<<NTOK * 6 / 4, 256, 0, stream>>>(PROJ, MIX);
        RwkvP P{shift_mu + l * 1024, decay_w0 + l * 256, decay_up + (size_t)l * 64 * 256, iclr_a0 + l * 256, iclr_up + (size_t)l * 64 * 256, gate_up + (size_t)l * 128 * 256,
                k_k + l * 256, k_a + l * 256, r_k + l * 256, lnx_g + l * 256, lnx_b + l * 256};
        for (int b = 0; b < 2; ++b) {
            k_rwkv_prep<<<SEQ, 256, 0, stream>>>(PROJ, b * SEQ, P, rR, rW, rK, rV, rA, rB, rG, rBON);
            k_rwkv_scan<<<4, 64, 0, stream>>>(rR, rW, rK, rV, rA, rB, rY);
            k_rwkv_out<<<SEQ, 256, 0, stream>>>(rY, rV, rG, rBON, P, b * SEQ, MIX);
        }
        k_gemm_naive<bf16_t, float><<<dim3(D / 64, NTOK / 64), 256, 0, stream>>>(MIX, D, w_out + (size_t)l * D * D, D, M1, D, D);
        k_ln<<<NTOK, 256, 0, stream>>>(H, M1, ALPHA, ln1_g + l * D, ln1_b + l * D, M1);
        k_moe_naive<<<NTOK, 256, 0, stream>>>(M1, router_w, router_bias, w_gate + (size_t)l * 16 * 1024 * 256, w_up + (size_t)l * 16 * 1024 * 256, w_down + (size_t)l * 16 * 256 * 1024, F);
        k_ln<<<NTOK, 256, 0, stream>>>(M1, F, ALPHA, ln2_g + l * D, ln2_b + l * D, l == 1 ? (float*)d_out : H);
    }
}
```

```cpp
#include <hip/hip_runtime.h>
#include <stdint.h>

typedef unsigned short bf16_t;
typedef short bf16x8 __attribute__((ext_vector_type(8)));
typedef float f32x4 __attribute__((ext_vector_type(4)));
typedef float f32x2 __attribute__((ext_vector_type(2)));
typedef float f32x16 __attribute__((ext_vector_type(16)));
typedef unsigned u32x4 __attribute__((ext_vector_type(4)));
typedef unsigned u32x2 __attribute__((ext_vector_type(2)));
#define LAS __attribute__((address_space(3)))

__device__ __forceinline__ bf16_t f2bf(float f) { unsigned u = __float_as_uint(f); u += 0x7FFFu + ((u >> 16) & 1u); return (bf16_t)(u >> 16); }
__device__ __forceinline__ float bf2f(bf16_t b) { return __uint_as_float(((unsigned)b) << 16); }
typedef __bf16 bf16v2_t __attribute__((ext_vector_type(2)));
__device__ __forceinline__ unsigned pk2(float lo, float hi) { f32x2 f = {lo, hi}; bf16v2_t b = __builtin_convertvector(f, bf16v2_t); return __builtin_bit_cast(unsigned, b); }
__device__ __forceinline__ float bflo(unsigned w) { return __uint_as_float(w << 16); }
__device__ __forceinline__ float bfhi(unsigned w) { return __uint_as_float(w & 0xFFFF0000u); }

constexpr int D = 1024, SEQ = 8192, NTOK = 16384, INC = 2816;
constexpr int PN = 2304;
constexpr int C_QA = 0, C_KA = 384, C_PB = 512, C_QC = 1536, C_KC = 1920;
constexpr int VT_LD = NTOK;
constexpr float ALPHA = 1.41421356237f;
constexpr int NTHR = 512;

__device__ __forceinline__ int perm16(int i) { return (i & 3) | ((i & 4) << 1) | ((i & 8) >> 1); }
__device__ __forceinline__ int vt_pos(int t) { return (t & ~15) | perm16(t & 15); }

__device__ __forceinline__ float wave_sum(float v) {
#pragma unroll
    for (int o = 32; o > 0; o >>= 1) v += __shfl_xor(v, o, 64);
    return v;
}
__device__ __forceinline__ float wave_max(float v) {
#pragma unroll
    for (int o = 32; o > 0; o >>= 1) v = fmaxf(v, __shfl_xor(v, o, 64));
    return v;
}
__device__ __forceinline__ float sigmoidf_(float x) { return 1.0f / (1.0f + __expf(-x)); }

struct ConvP { const float *w_in, *w_out, *w_gate, *w_up, *w_down, *decay_up, *iclr_up, *gate_up; bf16_t *WIN_T, *WOUT_T, *W1_T, *WD_T, *DUP_T, *IUP_T, *GUP_T; };
constexpr int CONV_UNITS = 704 + 256 + 2048 + 1024 + 16;
__device__ __forceinline__ int orig_col(int n) { return n < 512 ? n : (n < 2304 ? n + 128 : (n < 2432 ? n - 2304 + 512 : n)); }
__device__ __forceinline__ void conv_unit(const ConvP& P, int u, float* tile  ) {
    const float* src; int ld_src, col0, k0; bf16_t* dst; int ld_dst;
    if (u < 704) { const int nt = u >> 4, kt = u & 15; src = P.w_in; ld_src = INC; col0 = orig_col(nt * 64); k0 = kt * 64; dst = P.WIN_T + (size_t)nt * 64 * 1024; ld_dst = 1024; }
    else if (u < 960) { const int v = u - 704, nt = v >> 4, kt = v & 15; src = P.w_out; ld_src = 1024; col0 = nt * 64; k0 = kt * 64; dst = P.WOUT_T + (size_t)nt * 64 * 1024; ld_dst = 1024; }
    else if (u < 3008) { const int v = u - 960, e = v >> 7, r = v & 127, nt = r >> 4, kt = r & 15, j0 = nt * 64, ct = j0 >> 8, jj = j0 & 255;
        src = (jj < 128 ? P.w_gate : P.w_up) + (size_t)e * 1024 * 256; ld_src = 256; col0 = ct * 128 + (jj & 127); k0 = kt * 64; dst = P.W1_T + (size_t)e * 512 * 1024 + (size_t)j0 * 1024; ld_dst = 1024; }
    else if (u >= 4032) { const int v = u - 4032;
        if (v < 4) { src = P.decay_up; ld_src = 256; col0 = v * 64; k0 = 0; dst = P.DUP_T + (size_t)v * 64 * 64; ld_dst = 64; }
        else if (v < 8) { src = P.iclr_up; ld_src = 256; col0 = (v - 4) * 64; k0 = 0; dst = P.IUP_T + (size_t)(v - 4) * 64 * 64; ld_dst = 64; }
        else { const int w = v - 8; src = P.gate_up; ld_src = 256; col0 = (w >> 1) * 64; k0 = (w & 1) * 64; dst = P.GUP_T + (size_t)(w >> 1) * 64 * 128; ld_dst = 128; } }
    else { const int v = u - 3008, e = v >> 6, r = v & 63, nt = r >> 2, kt = r & 3; src = P.w_down + (size_t)e * 256 * 1024; ld_src = 1024; col0 = nt * 64; k0 = kt * 64; dst = P.WD_T + (size_t)e * 1024 * 256 + (size_t)nt * 64 * 256; ld_dst = 256; }
    const int tid = threadIdx.x;
    { const int ty = tid >> 4, tx = tid & 15;
#pragma unroll
      for (int rr = 0; rr < 2; ++rr) { const int k = ty + 32 * rr; const f32x4 v = *(const f32x4*)(src + (size_t)(k0 + k) * ld_src + col0 + 4 * tx);
          tile[k * 65 + 4 * tx + 0] = v[0]; tile[k * 65 + 4 * tx + 1] = v[1]; tile[k * 65 + 4 * tx + 2] = v[2]; tile[k * 65 + 4 * tx + 3] = v[3]; } }
    __syncthreads();
    { const int n = tid >> 3, kc = (tid & 7) * 8; u32x4 w;
      w[0] = pk2(tile[(kc + 0) * 65 + n], tile[(kc + 1) * 65 + n]); w[1] = pk2(tile[(kc + 2) * 65 + n], tile[(kc + 3) * 65 + n]);
      w[2] = pk2(tile[(kc + 4) * 65 + n], tile[(kc + 5) * 65 + n]); w[3] = pk2(tile[(kc + 6) * 65 + n], tile[(kc + 7) * 65 + n]);
      *(u32x4*)(dst + (size_t)n * ld_dst + k0 + kc) = w; }
    __syncthreads();
}
__global__ void __launch_bounds__(NTHR, 2) k_convert(ConvP P) {
    __shared__ float tile[64 * 65];
    for (int u = blockIdx.x; u < CONV_UNITS; u += gridDim.x) conv_unit(P, u, tile);
}

__device__ __forceinline__ void ln_finish_store(const float (&v)[16], const float* __restrict__ g, const float* __restrict__ b, int lane, bf16_t* outb, float* outf) {
    float s = 0.f;
#pragma unroll
    for (int i = 0; i < 16; ++i) s += v[i];
    const float mu = wave_sum(s) * (1.0f / D);
    float q = 0.f;
#pragma unroll
    for (int i = 0; i < 16; ++i) { const float d = v[i] - mu; q += d * d; }
    const float rs = rsqrtf(wave_sum(q) * (1.0f / D) + 1e-5f);
#pragma unroll
    for (int i = 0; i < 4; ++i) { const int col = lane * 4 + 256 * i; const f32x4 gv = *(const f32x4*)(g + col), bv = *(const f32x4*)(b + col);
        float o[4];
#pragma unroll
        for (int j = 0; j < 4; ++j) o[j] = (v[4 * i + j] - mu) * rs * gv[j] + bv[j];
        if (outb) { u32x2 w; w[0] = pk2(o[0], o[1]); w[1] = pk2(o[2], o[3]); *(u32x2*)(outb + col) = w; }
        if (outf) { *(f32x4*)(outf + col) = (f32x4){o[0], o[1], o[2], o[3]}; } }
}
__global__ void __launch_bounds__(NTHR, 2) k_ln0(const float* __restrict__ x, const float* __restrict__ g, const float* __restrict__ b, bf16_t* __restrict__ H) {
    const int lane = threadIdx.x & 63, wv = threadIdx.x >> 6;
    for (int t = blockIdx.x * 8 + wv; t < NTOK; t += gridDim.x * 8) {
        float v[16];
#pragma unroll
        for (int i = 0; i < 4; ++i) { const f32x4 a = *(const f32x4*)(x + (size_t)t * D + lane * 4 + 256 * i); v[4 * i] = a[0]; v[4 * i + 1] = a[1]; v[4 * i + 2] = a[2]; v[4 * i + 3] = a[3]; }
        ln_finish_store(v, g, b, lane, H + (size_t)t * D, nullptr);
    }
}
__global__ void __launch_bounds__(NTHR, 2) k_ln1(const bf16_t* __restrict__ Y1, const float* __restrict__ g, const float* __restrict__ b, bf16_t* __restrict__ H1) {
    const int lane = threadIdx.x & 63, wv = threadIdx.x >> 6;
    for (int t = blockIdx.x * 8 + wv; t < NTOK; t += gridDim.x * 8) {
        float v[16];
#pragma unroll
        for (int i = 0; i < 4; ++i) { const u32x2 a = *(const u32x2*)(Y1 + (size_t)t * D + lane * 4 + 256 * i); v[4 * i] = bflo(a[0]); v[4 * i + 1] = bfhi(a[0]); v[4 * i + 2] = bflo(a[1]); v[4 * i + 3] = bfhi(a[1]); }
        ln_finish_store(v, g, b, lane, H1 + (size_t)t * D, nullptr);
    }
}
__global__ void __launch_bounds__(NTHR, 2) k_ln2(const bf16_t* __restrict__ H1, const float* __restrict__ F, const float* __restrict__ g, const float* __restrict__ b, bf16_t* Hout, float* Fout) {
    const int lane = threadIdx.x & 63, wv = threadIdx.x >> 6;
    for (int t = blockIdx.x * 8 + wv; t < NTOK; t += gridDim.x * 8) {
        float v[16];
#pragma unroll
        for (int i = 0; i < 4; ++i) { const u32x2 a = *(const u32x2*)(H1 + (size_t)t * D + lane * 4 + 256 * i); const f32x4 f = *(const f32x4*)(F + (size_t)t * D + lane * 4 + 256 * i);
            v[4 * i] = ALPHA * bflo(a[0]) + f[0]; v[4 * i + 1] = ALPHA * bfhi(a[0]) + f[1]; v[4 * i + 2] = ALPHA * bflo(a[1]) + f[2]; v[4 * i + 3] = ALPHA * bfhi(a[1]) + f[3]; }
        ln_finish_store(v, g, b, lane, Hout ? Hout + (size_t)t * D : nullptr, Fout ? Fout + (size_t)t * D : nullptr);
    }
}

namespace pg8 {
constexpr int BM = 256, BK = 64, HALF = 128, HTB = HALF * BK * 2, STAGE_BYTES = 8 * HTB, NXCD = 8, WGM = 8;
__device__ __forceinline__ int lds_byte(int r, int c) { const int st = (r >> 4) * 2 + (c >> 5), rr = r & 15, cc = c & 31, ob = rr * 64 + cc * 2; return st * 1024 + (ob ^ (((ob >> 9) & 1) << 5)); }
__device__ __forceinline__ void stage_rc(int b, int& R, int& C) { const int st = b / 1024, sb = b % 1024, swz = sb ^ (((sb >> 9) & 1) << 5); R = (st >> 1) * 16 + swz / 64; C = (st & 1) * 32 + (swz % 64) / 2; }
__device__ __forceinline__ int perm32(int rho) { const int n = rho >> 4, i = rho & 15; return 8 * (i >> 2) + 4 * n + (i & 3); }
struct Unit { const char* a; const char* b; int row0, col0, kind, aux, n; };
__device__ __forceinline__ void tile_of(int L, int nM, int nN, int& pm, int& pn) {
    const int nwg = nM * nN; int wgid = L;
    { const int q = nwg / NXCD, r = nwg % NXCD, xcd = wgid % NXCD, off = wgid / NXCD; wgid = (xcd < r ? xcd * (q + 1) : r * (q + 1) + (xcd - r) * q) + off; }
    const int nig = WGM * nN, gid = wgid / nig, fm = gid * WGM, gsz = (nM - fm) < WGM ? (nM - fm) : WGM;
    pm = fm + ((wgid % nig) % gsz); pn = (wgid % nig) / gsz;
}
template <class Epi, class Sched, bool GATHER = false>
__device__ __forceinline__ void gemm_phase(LAS unsigned char* lds, const int K, const Sched& S, const Epi& E) {
    const int tid = threadIdx.x, wid = __builtin_amdgcn_readfirstlane(tid >> 6), lane = tid & 63, wr = wid >> 2, wc = wid & 3, fr = lane & 15, fq = lane >> 4;
    const int nt = K / BK;
    unsigned voffB[2], vAc[2][2], vAn[2][2]; int stR[2], stC[2];
    const size_t kstep = (size_t)(BK * 2);
    const size_t hstep = (size_t)HALF * K * 2;
#pragma unroll
    for (int i = 0; i < 2; ++i) { int R, C; stage_rc(tid * 16 + i * 8192, R, C); const int Rb = Epi::PERM ? ((R & ~31) + perm32(R & 31)) : R; stR[i] = R; stC[i] = C;
        voffB[i] = (unsigned)(Rb * K + C) * 2u;
#pragma unroll
        for (int hf = 0; hf < 2; ++hf) { vAc[hf][i] = (unsigned)(R * K + C) * 2u + (unsigned)(hf * hstep); vAn[hf][i] = vAc[hf][i]; } }
    const unsigned ldsw = (unsigned)wid * 1024u;
    const int aoff = lds_byte(wr * 64 + fr, fq * 8), boff = lds_byte(wc * 32 + fr, fq * 8);
#define PG8_SA(b, h) (((b) * 2 + (h)) * HTB)
#define PG8_SB(b, h) ((4 + (b) * 2 + (h)) * HTB)
#define PG8_STAGE(bufoff, gbase, voff) do { _Pragma("unroll") for (int _i = 0; _i < 2; ++_i) \
        __builtin_amdgcn_global_load_lds((const unsigned*)((const char*)(gbase) + (voff)[_i]), (LAS unsigned*)(lds + (bufoff) + ldsw + _i * 8192), 16, 0, 0); } while (0)
#define PG8_LDA(dst, b, h) do { _Pragma("unroll") for (int m = 0; m < 4; ++m) _Pragma("unroll") for (int k = 0; k < 2; ++k) dst[m][k] = *(const LAS bf16x8*)(lds + PG8_SA(b, h) + aoff + m * 2048 + k * 1024); } while (0)
#define PG8_LDB(dst, b, h) do { _Pragma("unroll") for (int n = 0; n < 2; ++n) _Pragma("unroll") for (int k = 0; k < 2; ++k) dst[n][k] = *(const LAS bf16x8*)(lds + PG8_SB(b, h) + boff + n * 2048 + k * 1024); } while (0)
#define PG8_MMA(ai, bj, At, Bt) do { __builtin_amdgcn_s_setprio(1); _Pragma("unroll") for (int m = 0; m < 4; ++m) _Pragma("unroll") for (int n = 0; n < 2; ++n) _Pragma("unroll") for (int k = 0; k < 2; ++k) \
        acc[ai][bj][m][n] = __builtin_amdgcn_mfma_f32_16x16x32_bf16(Bt[n][k], At[m][k], acc[ai][bj][m][n], 0, 0, 0); __builtin_amdgcn_s_setprio(0); } while (0)
#define PG8_WAIT_V(n) asm volatile("s_waitcnt vmcnt(" #n ")" ::: "memory")
#define PG8_WAIT_L(n) asm volatile("s_waitcnt lgkmcnt(" #n ")" ::: "memory")
#define PG8_BAR __builtin_amdgcn_s_barrier()
#define PG8_SCHED __builtin_amdgcn_sched_barrier(0)
    Unit cur, nxt; int ui = 0;
    if (!S.next(0, cur)) return;
    f32x4 acc[2][2][4][2];
#pragma unroll
    for (int a = 0; a < 2; ++a)
#pragma unroll
        for (int b = 0; b < 2; ++b)
#pragma unroll
            for (int m = 0; m < 4; ++m)
#pragma unroll
                for (int n = 0; n < 2; ++n) acc[a][b][m][n] = (f32x4){0.f, 0.f, 0.f, 0.f};
    bf16x8 At[4][2], B0[2][2], B1[2][2];
    const char* cA = cur.a; const char* cB = cur.b;
    if constexpr (GATHER) {
#pragma unroll
        for (int i = 0; i < 2; ++i)
#pragma unroll
            for (int hf = 0; hf < 2; ++hf) { vAc[hf][i] = S.a_off(cur, hf * HALF + stR[i]) + (unsigned)stC[i] * 2u; vAn[hf][i] = vAc[hf][i]; }
    }
    PG8_STAGE(PG8_SB(0, 0), cB, voffB); PG8_STAGE(PG8_SA(0, 0), cA, vAc[0]); PG8_STAGE(PG8_SB(0, 1), cB + hstep, voffB); PG8_STAGE(PG8_SA(0, 1), cA, vAc[1]);
    if (wr == 1) PG8_BAR;
    PG8_WAIT_V(4); PG8_BAR;
    PG8_STAGE(PG8_SB(1, 0), cB + kstep, voffB); PG8_STAGE(PG8_SA(1, 0), cA + kstep, vAc[0]); PG8_STAGE(PG8_SB(1, 1), cB + hstep + kstep, voffB);
    PG8_WAIT_V(6); PG8_BAR;
    for (;;) {
        const bool has_next = S.next(ui + 1, nxt);
        const char* nA = has_next ? nxt.a : cA; const char* nB = has_next ? nxt.b : cB;
        if constexpr (GATHER) {
            if (has_next) {
#pragma unroll
                for (int i = 0; i < 2; ++i)
#pragma unroll
                    for (int hf = 0; hf < 2; ++hf) vAn[hf][i] = S.a_off(nxt, hf * HALF + stR[i]) + (unsigned)stC[i] * 2u;
            }
        }
        for (int t = 0; t < nt; t += 2) {
            const bool last = (t == nt - 2);
            const char* a1 = cA + (size_t)(t + 1) * kstep;
            const char* a2 = last ? nA : cA + (size_t)(t + 2) * kstep; const char* b2 = last ? nB : cB + (size_t)(t + 2) * kstep;
            const char* a3 = a2 + kstep; const char* b3 = b2 + kstep;
            unsigned vA2[2][2];
#pragma unroll
            for (int i = 0; i < 2; ++i)
#pragma unroll
                for (int hf = 0; hf < 2; ++hf) vA2[hf][i] = (GATHER && last) ? vAn[hf][i] : vAc[hf][i];
            PG8_LDB(B0, 0, 0); PG8_SCHED; PG8_LDA(At, 0, 0); PG8_STAGE(PG8_SA(1, 1), a1, vAc[1]);
            PG8_WAIT_L(8); PG8_BAR; PG8_WAIT_L(0); PG8_MMA(0, 0, At, B0); PG8_BAR; PG8_SCHED;
            PG8_LDB(B1, 0, 1); PG8_STAGE(PG8_SB(0, 0), b2, voffB);
            PG8_BAR; PG8_WAIT_L(0); PG8_MMA(0, 1, At, B1); PG8_BAR;
            PG8_LDA(At, 0, 1); PG8_STAGE(PG8_SA(0, 0), a2, vA2[0]);
            PG8_BAR; PG8_WAIT_L(0); PG8_MMA(1, 0, At, B0); PG8_BAR; PG8_SCHED;
            PG8_STAGE(PG8_SB(0, 1), b2 + hstep, voffB);
            PG8_WAIT_V(6); PG8_BAR; PG8_MMA(1, 1, At, B1); PG8_BAR;
            PG8_LDB(B0, 1, 0); PG8_SCHED; PG8_LDA(At, 1, 0); PG8_STAGE(PG8_SA(0, 1), a2, vA2[1]);
            PG8_WAIT_L(8); PG8_BAR; PG8_WAIT_L(0); PG8_MMA(0, 0, At, B0); PG8_BAR; PG8_SCHED;
            PG8_LDB(B1, 1, 1); PG8_STAGE(PG8_SB(1, 0), b3, voffB);
            PG8_BAR; PG8_WAIT_L(0); PG8_MMA(0, 1, At, B1); PG8_BAR;
            PG8_LDA(At, 1, 1); PG8_STAGE(PG8_SA(1, 0), a3, vA2[0]);
            PG8_BAR; PG8_WAIT_L(0); PG8_MMA(1, 0, At, B0); PG8_BAR; PG8_SCHED;
            PG8_STAGE(PG8_SB(1, 1), b3 + hstep, voffB);
            PG8_WAIT_V(6); PG8_BAR; PG8_MMA(1, 1, At, B1); PG8_BAR;
        }
        E(acc, cur, wr, wc, fr, fq);
        if (!has_next) break;
#pragma unroll
        for (int a = 0; a < 2; ++a)
#pragma unroll
            for (int b = 0; b < 2; ++b)
#pragma unroll
                for (int m = 0; m < 4; ++m)
#pragma unroll
                    for (int n = 0; n < 2; ++n) acc[a][b][m][n] = (f32x4){0.f, 0.f, 0.f, 0.f};
        cur = nxt; cA = nA; cB = nB; ++ui;
#pragma unroll
        for (int i = 0; i < 2; ++i)
#pragma unroll
            for (int hf = 0; hf < 2; ++hf) vAc[hf][i] = vAn[hf][i];
    }
    PG8_WAIT_V(0);
    if (wr == 0) PG8_BAR;
    PG8_BAR;
#undef PG8_SA
#undef PG8_SB
#undef PG8_STAGE
#undef PG8_LDA
#undef PG8_LDB
#undef PG8_MMA
#undef PG8_WAIT_V
#undef PG8_WAIT_L
#undef PG8_BAR
#undef PG8_SCHED
}
}

struct SchedProjN {
    const char* H; const char* W; int G, c;
    __device__ __forceinline__ bool next(int i, pg8::Unit& u) const {
        const int L = i * G + c; if (L >= 576) return false; int pm, pn;
        pg8::tile_of(L, 64, 9, pm, pn); u.a = H + (size_t)pm * 256 * 2048; u.b = W + (size_t)pn * 256 * 2048; u.kind = 0;
        u.row0 = pm * 256; u.col0 = pn * 256; u.aux = 0; u.n = 0; return true;
    }
};
struct SchedProjV {
    const char* H; const char* W; int G, c;
    __device__ __forceinline__ bool next(int i, pg8::Unit& u) const {
        const int L = i * G + c - 64; if (L < 0 || L >= 128 || i > 0) return false; int pm, pn;
        pg8::tile_of(L, 2, 64, pm, pn); u.a = W + (size_t)(2304 + pm * 256) * 2048; u.b = H + (size_t)pn * 256 * 2048; u.kind = 1;
        u.row0 = pm * 256; u.col0 = pn * 256; u.aux = 0; u.n = 0; return true;
    }
};
struct EpiProjN {
    static constexpr bool PERM = true;
    bf16_t* projn;
    __device__ __forceinline__ void operator()(const f32x4 (&acc)[2][2][4][2], const pg8::Unit& u, int wr, int wc, int fr, int fq) const {
        const int row0 = u.row0 + wr * 64 + fr, col0 = u.col0 + wc * 32 + 8 * fq;
#pragma unroll
        for (int ai = 0; ai < 2; ++ai)
#pragma unroll
            for (int m = 0; m < 4; ++m) { bf16_t* rowp = projn + (size_t)(row0 + ai * 128 + m * 16) * PN + col0;
#pragma unroll
                for (int bj = 0; bj < 2; ++bj) { const f32x4 v0 = acc[ai][bj][m][0], v1 = acc[ai][bj][m][1]; u32x4 w;
                    w[0] = pk2(v0[0], v0[1]); w[1] = pk2(v0[2], v0[3]); w[2] = pk2(v1[0], v1[1]); w[3] = pk2(v1[2], v1[3]);
                    *(u32x4*)(rowp + bj * 128) = w; } }
    }
};
struct EpiProjV {
    static constexpr bool PERM = true;
    bf16_t* vt;
    __device__ __forceinline__ void operator()(const f32x4 (&acc)[2][2][4][2], const pg8::Unit& u, int wr, int wc, int fr, int fq) const {
        const int row0 = u.row0 + wr * 64 + fr;
#pragma unroll
        for (int ai = 0; ai < 2; ++ai)
#pragma unroll
            for (int m = 0; m < 4; ++m) { bf16_t* rowp = vt + (size_t)(row0 + ai * 128 + m * 16) * VT_LD + (u.col0 + wc * 32 + 16 * (fq >> 1) + 4 * (fq & 1));
#pragma unroll
                for (int bj = 0; bj < 2; ++bj)
#pragma unroll
                    for (int n = 0; n < 2; ++n) { const f32x4 v = acc[ai][bj][m][n]; u32x2 w; w[0] = pk2(v[0], v[1]); w[1] = pk2(v[2], v[3]);
                        *(u32x2*)(rowp + bj * 128 + 8 * n) = w; } }
    }
};
__device__ __forceinline__ void phase_proj(LAS unsigned char* lds, const bf16_t* H, const bf16_t* WIN_T, bf16_t* projn, bf16_t* vt, int G, int c) {
    { SchedProjN S{(const char*)H, (const char*)WIN_T, G, c}; EpiProjN E{projn}; pg8::gemm_phase<EpiProjN, SchedProjN>(lds, 1024, S, E); }
    { SchedProjV S{(const char*)H, (const char*)WIN_T, G, c}; EpiProjV E{vt}; pg8::gemm_phase<EpiProjV, SchedProjV>(lds, 1024, S, E); }
}
__global__ void __launch_bounds__(NTHR, 2) k_proj(const bf16_t* H, const bf16_t* WIN_T, bf16_t* projn, bf16_t* vt) {
    extern __shared__ __attribute__((aligned(16))) unsigned char shm[];
    phase_proj((LAS unsigned char*)shm, H, WIN_T, projn, vt, (int)gridDim.x, (int)blockIdx.x);
}
struct SchedWout {
    const char* A; const char* W; int G, c;
    __device__ __forceinline__ bool next(int i, pg8::Unit& u) const {
        const int L = i * G + c; if (L >= 256) return false; int pm, pn; pg8::tile_of(L, 64, 4, pm, pn);
        u.a = A + (size_t)pm * 256 * 2048; u.b = W + (size_t)pn * 256 * 2048; u.row0 = pm * 256; u.col0 = pn * 256; u.kind = 0; u.aux = 0; u.n = 0; return true;
    }
};
struct EpiWout {
    static constexpr bool PERM = true;
    const bf16_t* H; bf16_t* Y1;
    __device__ __forceinline__ void operator()(const f32x4 (&acc)[2][2][4][2], const pg8::Unit& u, int wr, int wc, int fr, int fq) const {
        const int row0 = u.row0 + wr * 64 + fr, col0 = u.col0 + wc * 32 + 8 * fq;
#pragma unroll
        for (int ai = 0; ai < 2; ++ai)
#pragma unroll
            for (int m = 0; m < 4; ++m) { const size_t off = (size_t)(row0 + ai * 128 + m * 16) * D + col0;
#pragma unroll
                for (int bj = 0; bj < 2; ++bj) { const f32x4 v0 = acc[ai][bj][m][0], v1 = acc[ai][bj][m][1]; const u32x4 h = *(const u32x4*)(H + off + bj * 128); u32x4 w;
                    w[0] = pk2(ALPHA * bflo(h[0]) + v0[0], ALPHA * bfhi(h[0]) + v0[1]); w[1] = pk2(ALPHA * bflo(h[1]) + v0[2], ALPHA * bfhi(h[1]) + v0[3]);
                    w[2] = pk2(ALPHA * bflo(h[2]) + v1[0], ALPHA * bfhi(h[2]) + v1[1]); w[3] = pk2(ALPHA * bflo(h[3]) + v1[2], ALPHA * bfhi(h[3]) + v1[3]);
                    *(u32x4*)(Y1 + off + bj * 128) = w; } }
    }
};
__global__ void __launch_bounds__(NTHR, 2) k_wout(const bf16_t* MIX, const bf16_t* WOUT_T, const bf16_t* H, bf16_t* Y1) {
    extern __shared__ __attribute__((aligned(16))) unsigned char shm[];
    SchedWout S{(const char*)MIX, (const char*)WOUT_T, (int)gridDim.x, (int)blockIdx.x};
    EpiWout E{H, Y1};
    pg8::gemm_phase<EpiWout, SchedWout>((LAS unsigned char*)shm, 1024, S, E);
}

#define MFMA32(a, b, c) __builtin_amdgcn_mfma_f32_32x32x16_bf16((a), (b), (c), 0, 0, 0)
template <int S_> __device__ __forceinline__ bf16x8 pack8(const f32x16& x) {
    u32x4 p; p[0] = pk2(x[8 * S_], x[8 * S_ + 1]); p[1] = pk2(x[8 * S_ + 2], x[8 * S_ + 3]); p[2] = pk2(x[8 * S_ + 4], x[8 * S_ + 5]); p[3] = pk2(x[8 * S_ + 6], x[8 * S_ + 7]);
    return __builtin_bit_cast(bf16x8, p);
}
__device__ __forceinline__ f32x16 zero16() { f32x16 z;
#pragma unroll
    for (int i = 0; i < 16; ++i) z[i] = 0.f;
    return z; }
constexpr float LOG2E = 1.4426950408889634f;
__device__ __forceinline__ int t5_bucket(int dist) {
    if (dist < 16) return dist;
    int large = 16 + (int)(logf((float)dist * (1.0f / 16.0f)) / 2.0794415416798357f * 16.0f);
    return large < 31 ? large : 31;
}
__device__ __forceinline__ void attn_c_unit(const bf16_t* __restrict__ projn, const bf16_t* __restrict__ vt, bf16_t* __restrict__ mix, int b, int qt, int h, int lane) {
    const int q = lane & 31, hh = lane >> 5;
    const size_t tq = (size_t)b * SEQ + qt * 32 + q;
    bf16x8 qf[4];
#pragma unroll
    for (int s = 0; s < 4; ++s) qf[s] = *(const bf16x8*)(projn + tq * PN + C_QC + h * 64 + 16 * s + 8 * hh);
    bf16x8 tri[2];
#pragma unroll
    for (int s = 0; s < 2; ++s)
#pragma unroll
        for (int j = 0; j < 8; ++j) { const int kp = 16 * s + 8 * (j >> 2) + 4 * hh + (j & 3); tri[s][j] = (short)(kp > q ? 0x3F80 : 0); }
    f32x16 O0 = zero16(), O1 = zero16(); float carry = 0.f;
    const float c2 = 0.125f * LOG2E;
    for (int kt = qt; kt >= 0; --kt) {
        const size_t tk = (size_t)b * SEQ + kt * 32;
        bf16x8 kf[4];
#pragma unroll
        for (int s = 0; s < 4; ++s) kf[s] = *(const bf16x8*)(projn + (tk + q) * PN + C_KC + h * 64 + 16 * s + 8 * hh);
        bf16x8 vf[2][2];
#pragma unroll
        for (int s = 0; s < 2; ++s)
#pragma unroll
            for (int dt = 0; dt < 2; ++dt) vf[s][dt] = *(const bf16x8*)(vt + (size_t)(128 + h * 64 + dt * 32 + q) * VT_LD + tk + 16 * s + 8 * hh);
        f32x16 Z = zero16();
#pragma unroll
        for (int s = 0; s < 4; ++s) Z = MFMA32(kf[s], qf[s], Z);
        const bool diag = (kt == qt);
        f32x16 lk, lb;
#pragma unroll
        for (int r = 0; r < 16; ++r) {
            const float z = Z[r] * c2;
            const float sp = fmaxf(z, 0.f) + __builtin_amdgcn_logf(1.0f + __builtin_amdgcn_exp2f(-fabsf(z)));
            float l = -sp, bb = z - sp;
            if (diag) { const int krow = (r & 3) + 8 * (r >> 2) + 4 * hh; const bool valid = krow < q; l = valid ? l : 0.f; bb = valid ? bb : -1e30f; }
            lk[r] = l; lb[r] = bb;
        }
        f32x16 Sx;
#pragma unroll
        for (int r = 0; r < 16; ++r) Sx[r] = carry;
        Sx = MFMA32(tri[0], pack8<0>(lk), Sx);
        Sx = MFMA32(tri[1], pack8<1>(lk), Sx);
        f32x16 W; float tot = 0.f;
#pragma unroll
        for (int r = 0; r < 16; ++r) { W[r] = __builtin_amdgcn_exp2f(lb[r] + Sx[r]); tot += lk[r]; }
        tot += __shfl_xor(tot, 32, 64);
        carry += tot;
        { const bf16x8 wf = pack8<0>(W); O0 = MFMA32(vf[0][0], wf, O0); O1 = MFMA32(vf[0][1], wf, O1); }
        { const bf16x8 wf = pack8<1>(W); O0 = MFMA32(vf[1][0], wf, O0); O1 = MFMA32(vf[1][1], wf, O1); }
        if (__all(carry < -90.0f)) break;
    }
    bf16_t* op = mix + tq * D + 640 + h * 64 + 4 * hh;
#pragma unroll
    for (int g = 0; g < 4; ++g) {
        u32x2 w; w[0] = pk2(O0[4 * g], O0[4 * g + 1]); w[1] = pk2(O0[4 * g + 2], O0[4 * g + 3]); *(u32x2*)(op + 8 * g) = w;
        u32x2 w1; w1[0] = pk2(O1[4 * g], O1[4 * g + 1]); w1[1] = pk2(O1[4 * g + 2], O1[4 * g + 3]); *(u32x2*)(op + 32 + 8 * g) = w1;
    }
}
__device__ __forceinline__ void attn_a_unit(const bf16_t* __restrict__ projn, const bf16_t* __restrict__ vt, const float* __restrict__ sinks, const LAS float* biasL,
                                            bf16_t* __restrict__ mix, int b, int qt, int hq, int lane) {
    const int q = lane & 31, hh = lane >> 5, kv = hq / 3;
    const size_t tq = (size_t)b * SEQ + qt * 32 + q;
    bf16x8 qf[4];
#pragma unroll
    for (int s = 0; s < 4; ++s) qf[s] = *(const bf16x8*)(projn + tq * PN + C_QA + hq * 64 + 16 * s + 8 * hh);
    const float c2 = 0.125f * LOG2E;
    const float sink2 = sinks[hq] * LOG2E;
    f32x16 L[5]; float m2 = sink2;
#pragma unroll
    for (int i = 0; i < 5; ++i) {
        const int kt = qt - 4 + i;
        if (kt >= 0) {
            const size_t tk = (size_t)b * SEQ + kt * 32;
            bf16x8 kf[4];
#pragma unroll
            for (int s = 0; s < 4; ++s) kf[s] = *(const bf16x8*)(projn + (tk + q) * PN + C_KA + kv * 64 + 16 * s + 8 * hh);
            f32x16 Z = zero16();
#pragma unroll
            for (int s = 0; s < 4; ++s) Z = MFMA32(kf[s], qf[s], Z);
#pragma unroll
            for (int r = 0; r < 16; ++r) {
                const int krow = (r & 3) + 8 * (r >> 2) + 4 * hh; const int dist = (4 - i) * 32 + q - krow;
                const bool valid = (i == 0) ? (dist < 128) : ((i == 4) ? (dist >= 0) : true);
                const float l2 = valid ? Z[r] * c2 + biasL[hq * 128 + (dist & 127)] : -INFINITY;
                L[i][r] = l2; m2 = fmaxf(m2, l2);
            }
        } else {
#pragma unroll
            for (int r = 0; r < 16; ++r) L[i][r] = -INFINITY;
        }
    }
    m2 = fmaxf(m2, __shfl_xor(m2, 32, 64));
    float den = 0.f;
#pragma unroll
    for (int i = 0; i < 5; ++i)
#pragma unroll
        for (int r = 0; r < 16; ++r) { const float p = __builtin_amdgcn_exp2f(L[i][r] - m2); L[i][r] = p; den += p; }
    den += __shfl_xor(den, 32, 64);
    den += __builtin_amdgcn_exp2f(sink2 - m2);
    f32x16 O0 = zero16(), O1 = zero16();
#pragma unroll
    for (int i = 0; i < 5; ++i) {
        const int kt = qt - 4 + i;
        if (kt >= 0) {
            const size_t tk = (size_t)b * SEQ + kt * 32;
            const bf16_t* vp = vt + (size_t)(kv * 64 + q) * VT_LD + tk + 8 * hh;
            const bf16x8 v00 = *(const bf16x8*)(vp), v01 = *(const bf16x8*)(vp + (size_t)32 * VT_LD), v10 = *(const bf16x8*)(vp + 16), v11 = *(const bf16x8*)(vp + (size_t)32 * VT_LD + 16);
            { const bf16x8 pf = pack8<0>(L[i]); O0 = MFMA32(v00, pf, O0); O1 = MFMA32(v01, pf, O1); }
            { const bf16x8 pf = pack8<1>(L[i]); O0 = MFMA32(v10, pf, O0); O1 = MFMA32(v11, pf, O1); }
        }
    }
    const float inv = 1.0f / den;
    bf16_t* op = mix + tq * D + hq * 64 + 4 * hh;
#pragma unroll
    for (int g = 0; g < 4; ++g) {
        u32x2 w; w[0] = pk2(O0[4 * g] * inv, O0[4 * g + 1] * inv); w[1] = pk2(O0[4 * g + 2] * inv, O0[4 * g + 3] * inv); *(u32x2*)(op + 8 * g) = w;
        u32x2 w1; w1[0] = pk2(O1[4 * g] * inv, O1[4 * g + 1] * inv); w1[1] = pk2(O1[4 * g + 2] * inv, O1[4 * g + 3] * inv); *(u32x2*)(op + 32 + 8 * g) = w1;
    }
}
constexpr int ATT_UNITS = 2 * 256 * 6;
__device__ __forceinline__ void phase_attn(LAS unsigned char* lds, const bf16_t* projn, const bf16_t* vt, const float* sinks, const float* rel_bias, bf16_t* mix, int wave0, int nwaves) {
    LAS float* biasL = (LAS float*)lds;
    for (int i = threadIdx.x; i < 768; i += NTHR) { const int hq = i >> 7, dist = i & 127; biasL[i] = rel_bias[t5_bucket(dist) * 6 + hq] * LOG2E; }
    __syncthreads();
    const int lane = threadIdx.x & 63;
    for (int u = wave0; u < 2 * ATT_UNITS; u += nwaves) {
        const int v = u >= ATT_UNITS ? u - ATT_UNITS : u; const int h = v % 6, qt = (v / 6) & 255, b = v / 1536;
        if (u < ATT_UNITS) attn_c_unit(projn, vt, mix, b, qt, h, lane); else attn_a_unit(projn, vt, sinks, biasL, mix, b, qt, h, lane);
    }
}
__global__ void __launch_bounds__(NTHR, 2) k_attn(const bf16_t* projn, const bf16_t* vt, const float* sinks, const float* rel_bias, bf16_t* mix) {
    extern __shared__ __attribute__((aligned(16))) unsigned char shm[];
    phase_attn((LAS unsigned char*)shm, projn, vt, sinks, rel_bias, mix, (int)(blockIdx.x * 8 + (threadIdx.x >> 6)), (int)(gridDim.x * 8));
}

#define MFMA16(a, b, c) __builtin_amdgcn_mfma_f32_16x16x32_bf16((a), (b), (c), 0, 0, 0)
constexpr int LDW = 72;
constexpr int RBUF = 64 * LDW * 2;
constexpr int RW_LDS = 14 * RBUF + 4096 + 256;
struct RwkvW { const float *shift_mu, *decay_w0, *iclr_a0, *k_k, *k_a, *r_k, *lnx_g, *lnx_b; const bf16_t *DUP_T, *IUP_T, *GUP_T; };
struct RwkvG { bf16_t* PT; float* QT; bf16_t* GT; bf16_t* YL; bf16_t* S0; bf16_t* G; float* BON; };
constexpr size_t RWG_PT = 0, RWG_QT = RWG_PT + (size_t)1024 * 8192, RWG_GT = RWG_QT + (size_t)1024 * 16384, RWG_YL = RWG_GT + (size_t)1024 * 8192,
                 RWG_S0 = RWG_YL + (size_t)1024 * 8192, RWG_G = RWG_S0 + (size_t)1024 * 8192, RWG_BON = RWG_G + (size_t)NTOK * 256 * 2, RWG_END = RWG_BON + (size_t)NTOK * 4 * 4;

template <class F> __device__ __forceinline__ void mm64(const LAS bf16_t* X, const LAS bf16_t* Y, int wid, int lane, F epi) {
    const int rt = wid >> 1, chh = wid & 1, fr = lane & 15, fq = lane >> 4;
    f32x4 a0 = {0.f, 0.f, 0.f, 0.f}, a1 = {0.f, 0.f, 0.f, 0.f};
#pragma unroll
    for (int ks = 0; ks < 2; ++ks) {
        const bf16x8 a = *(const LAS bf16x8*)(X + (16 * rt + fr) * LDW + 32 * ks + 8 * fq);
        const bf16x8 b0 = *(const LAS bf16x8*)(Y + (32 * chh + fr) * LDW + 32 * ks + 8 * fq);
        const bf16x8 b1 = *(const LAS bf16x8*)(Y + (32 * chh + 16 + fr) * LDW + 32 * ks + 8 * fq);
        a0 = MFMA16(a, b0, a0); a1 = MFMA16(a, b1, a1);
    }
#pragma unroll
    for (int r = 0; r < 4; ++r) { epi(16 * rt + 4 * fq + r, 32 * chh + fr, a0[r]); epi(16 * rt + 4 * fq + r, 32 * chh + 16 + fr, a1[r]); }
}
__device__ __forceinline__ void shifted8(const bf16_t* cur, bool hasprev, const float* mu, float (&x)[8]) {
    const u32x4 cw = *(const u32x4*)cur; u32x4 pw = {0u, 0u, 0u, 0u}; if (hasprev) pw = *(const u32x4*)(cur - PN);
    const f32x4 m0 = *(const f32x4*)mu, m1 = *(const f32x4*)(mu + 4);
#pragma unroll
    for (int i = 0; i < 4; ++i) { const float c0 = bflo(cw[i]), c1 = bfhi(cw[i]), p0 = bflo(pw[i]), p1 = bfhi(pw[i]); const float ma = i < 2 ? m0[2 * i] : m1[2 * i - 4], mb = i < 2 ? m0[2 * i + 1] : m1[2 * i - 3];
        x[2 * i] = c0 + (p0 - c0) * ma; x[2 * i + 1] = c1 + (p1 - c1) * mb; }
}
__device__ __forceinline__ bf16x8 pack8f(const float (&x)[8]) { u32x4 p; p[0] = pk2(x[0], x[1]); p[1] = pk2(x[2], x[3]); p[2] = pk2(x[4], x[5]); p[3] = pk2(x[6], x[7]); return __builtin_bit_cast(bf16x8, p); }
__device__ __forceinline__ float fast_tanh(float x) { const float e = __expf(-2.0f * fabsf(x)); const float t = (1.0f - e) / (1.0f + e); return x < 0.f ? -t : t; }

__device__ __forceinline__ void rwkv_prep_unit(LAS unsigned char* lds, const bf16_t* __restrict__ projn, const RwkvW& W, const RwkvG& Gp, int b, int c, int h) {
    const int tid = threadIdx.x, wid = tid >> 6, lane = tid & 63, fr = lane & 15, fq = lane >> 4;
    const size_t tok0 = (size_t)b * SEQ + (size_t)c * 64; const bool first = (c == 0);
    const int uidx = (b * 128 + c) * 4 + h;
#define RB(i) ((LAS bf16_t*)(lds + (i) * RBUF))
    LAS float* LWs = (LAS float*)(lds + 8 * RBUF); LAS float* AAs = LWs + 64 * 65;
    LAS float* PART = (LAS float*)(lds + 14 * RBUF); LAS float* GCs = PART + 1024;
    {
        const int rt = wid >> 1, chh = wid & 1, t = 16 * rt + fr; const bool hasprev = !(first && t == 0);
        const bf16_t* cur = projn + (tok0 + t) * PN + C_PB;
        f32x4 aU[2], aA[2], aG[2];
#pragma unroll
        for (int n = 0; n < 2; ++n) { aU[n] = (f32x4){0.f, 0.f, 0.f, 0.f}; aA[n] = aU[n]; aG[n] = aU[n]; }
#pragma unroll
        for (int ks = 0; ks < 2; ++ks) {
            float x[8]; const int col = 768 + 32 * ks + 8 * fq; shifted8(cur + col, hasprev, W.shift_mu + col, x);
#pragma unroll
            for (int i = 0; i < 8; ++i) x[i] = fast_tanh(x[i]);
            const bf16x8 a = pack8f(x);
#pragma unroll
            for (int n = 0; n < 2; ++n) { const bf16x8 bb = *(const bf16x8*)(W.DUP_T + (size_t)(h * 64 + 32 * chh + 16 * n + fr) * 64 + 32 * ks + 8 * fq); aU[n] = MFMA16(a, bb, aU[n]); }
        }
#pragma unroll
        for (int ks = 0; ks < 2; ++ks) {
            float x[8]; const int col = 832 + 32 * ks + 8 * fq; shifted8(cur + col, hasprev, W.shift_mu + col, x);
            const bf16x8 a = pack8f(x);
#pragma unroll
            for (int n = 0; n < 2; ++n) { const bf16x8 bb = *(const bf16x8*)(W.IUP_T + (size_t)(h * 64 + 32 * chh + 16 * n + fr) * 64 + 32 * ks + 8 * fq); aA[n] = MFMA16(a, bb, aA[n]); }
        }
#pragma unroll
        for (int ks = 0; ks < 4; ++ks) {
            float x[8]; const int col = 896 + 32 * ks + 8 * fq; shifted8(cur + col, hasprev, W.shift_mu + col, x);
#pragma unroll
            for (int i = 0; i < 8; ++i) x[i] = sigmoidf_(x[i]);
            const bf16x8 a = pack8f(x);
#pragma unroll
            for (int n = 0; n < 2; ++n) { const bf16x8 bb = *(const bf16x8*)(W.GUP_T + (size_t)(h * 64 + 32 * chh + 16 * n + fr) * 128 + 32 * ks + 8 * fq); aG[n] = MFMA16(a, bb, aG[n]); }
        }
#pragma unroll
        for (int n = 0; n < 2; ++n)
#pragma unroll
            for (int r = 0; r < 4; ++r) { const int t_ = 16 * rt + 4 * fq + r, ch = 32 * chh + 16 * n + fr, cidx = h * 64 + ch;
                LWs[t_ * 65 + ch] = -0.6065306597f * sigmoidf_(aU[n][r] + W.decay_w0[cidx]);
                AAs[t_ * 65 + ch] = sigmoidf_(aA[n][r] + W.iclr_a0[cidx]);
                Gp.G[(tok0 + t_) * 256 + cidx] = f2bf(aG[n][r]); }
    }
    __syncthreads();
    {
        const int t = lane, cg = wid, col0 = h * 64 + cg * 8; const bool hasprev = !(first && t == 0);
        const bf16_t* cur = projn + (tok0 + t) * PN + C_PB;
        float r[8], k[8], v[8];
        shifted8(cur + col0, hasprev, W.shift_mu + col0, r); shifted8(cur + 256 + col0, hasprev, W.shift_mu + 256 + col0, k); shifted8(cur + 512 + col0, hasprev, W.shift_mu + 512 + col0, v);
        float lw[8], aa[8], L[8], LC[8], kk[8], km[8]; float ss = 0.f, bn = 0.f;
#pragma unroll
        for (int i = 0; i < 8; ++i) { lw[i] = LWs[t * 65 + cg * 8 + i]; aa[i] = AAs[t * 65 + cg * 8 + i]; }
#pragma unroll
        for (int i = 0; i < 8; ++i) { float x = lw[i];
#pragma unroll
            for (int o = 1; o < 64; o <<= 1) { const float n = __shfl_up(x, o, 64); if (lane >= o) x += n; }
            L[i] = x; LC[i] = __shfl(x, 63, 64); }
#pragma unroll
        for (int i = 0; i < 8; ++i) { const int cidx = col0 + i; kk[i] = k[i] * W.k_k[cidx]; ss += kk[i] * kk[i]; km[i] = k[i] * (1.0f + (aa[i] - 1.0f) * W.k_a[cidx]); bn += r[i] * km[i] * W.r_k[cidx]; }
        PART[cg * 64 + t] = ss; PART[512 + cg * 64 + t] = bn;
        __syncthreads();
        float sst = 0.f, bnt = 0.f;
#pragma unroll
        for (int g = 0; g < 8; ++g) { sst += PART[g * 64 + t]; bnt += PART[512 + g * 64 + t]; }
        if (cg == 0) Gp.BON[(tok0 + t) * 4 + h] = bnt;
        const float rn = rsqrtf(fmaxf(sst, 1e-24f));
        float at[8], bt[8], kt[8], rt_[8], bh[8], kh[8];
#pragma unroll
        for (int i = 0; i < 8; ++i) { const float kkn = kk[i] * rn; const float g = __expf(L[i]), gp = __expf(L[i] - lw[i]), gi = __expf(-L[i]), ge = __expf(LC[i] - L[i]);
            at[i] = -kkn * gp; bt[i] = kkn * aa[i] * gi; kt[i] = km[i] * gi; rt_[i] = r[i] * g; bh[i] = kkn * aa[i] * ge; kh[i] = km[i] * ge; }
        *(LAS bf16x8*)(RB(0) + t * LDW + cg * 8) = pack8f(at); *(LAS bf16x8*)(RB(1) + t * LDW + cg * 8) = pack8f(bt);
        *(LAS bf16x8*)(RB(2) + t * LDW + cg * 8) = pack8f(kt); *(LAS bf16x8*)(RB(3) + t * LDW + cg * 8) = pack8f(rt_);
#pragma unroll
        for (int i = 0; i < 8; ++i) { RB(4)[(cg * 8 + i) * LDW + t] = f2bf(at[i]); RB(5)[(cg * 8 + i) * LDW + t] = f2bf(bh[i]); RB(6)[(cg * 8 + i) * LDW + t] = f2bf(v[i]); RB(7)[(cg * 8 + i) * LDW + t] = f2bf(kh[i]); }
        if (t == 63) {
#pragma unroll
            for (int i = 0; i < 8; ++i) GCs[cg * 8 + i] = __expf(LC[i]); }
    }
    __syncthreads();
    mm64(RB(1), RB(0), wid, lane, [&](int j, int t, float v) { const float m = j < t ? v : 0.f; RB(8)[j * LDW + t] = f2bf(m + (j == t ? 1.0f : 0.f)); RB(9)[j * LDW + t] = f2bf(m); RB(10)[t * LDW + j] = f2bf(m); });
    mm64(RB(2), RB(0), wid, lane, [&](int j, int t, float v) { RB(11)[j * LDW + t] = f2bf(j < t ? v : 0.f); });
    mm64(RB(3), RB(1), wid, lane, [&](int t, int i, float v) { RB(12)[t * LDW + i] = f2bf(i <= t ? v : 0.f); });
    mm64(RB(3), RB(2), wid, lane, [&](int t, int j, float v) { RB(13)[t * LDW + j] = f2bf(j <= t ? v : 0.f); });
    __syncthreads();
    auto sq = [&](int sp, int spt, int dp, int dpt) { mm64(RB(sp), RB(spt), wid, lane, [&](int i, int j, float v) { RB(dp)[i * LDW + j] = f2bf(v); RB(dpt)[j * LDW + i] = f2bf(v); }); };
    auto tmu = [&](int st, int spt, int dt) { mm64(RB(st), RB(spt), wid, lane, [&](int i, int j, float v) { RB(dt)[i * LDW + j] = f2bf(v + bf2f(RB(st)[i * LDW + j])); }); };
    sq(9, 10, 0, 1); __syncthreads();
    tmu(8, 1, 2); sq(0, 1, 9, 10); __syncthreads();
    tmu(2, 10, 8); sq(9, 10, 0, 1); __syncthreads();
    tmu(8, 1, 2); sq(0, 1, 9, 10); __syncthreads();
    tmu(2, 10, 8); sq(9, 10, 0, 1); __syncthreads();
    tmu(8, 1, 2); __syncthreads();
    mm64(RB(5), RB(2), wid, lane, [&](int k2, int j, float v) { RB(9)[k2 * LDW + j] = f2bf(v); });
    mm64(RB(12), RB(2), wid, lane, [&](int t, int j, float v) { RB(10)[t * LDW + j] = f2bf(v); });
    __syncthreads();
    { bf16_t* PTu = Gp.PT + (size_t)uidx * 4096;
      mm64(RB(9), RB(4), wid, lane, [&](int k2, int k1, float v) { const float p = v + (k2 == k1 ? GCs[k2] : 0.f);
          const int rtk = k1 >> 4, q = (k1 >> 2) & 3, jj = k1 & 3, s_ = rtk >> 1, j = 4 * (rtk & 1) + jj;
          PTu[(((k2 >> 4) * 2 + s_) * 64 + q * 16 + (k2 & 15)) * 8 + j] = f2bf(p); }); }
    mm64(RB(9), RB(11), wid, lane, [&](int k2, int j, float v) { RB(0)[k2 * LDW + j] = f2bf(v + bf2f(RB(7)[k2 * LDW + j])); });
    { bf16_t* GTu = Gp.GT + (size_t)uidx * 4096;
      mm64(RB(10), RB(4), wid, lane, [&](int t, int k, float v) { GTu[t * 64 + k] = f2bf(v + bf2f(RB(3)[t * LDW + k])); }); }
    mm64(RB(10), RB(11), wid, lane, [&](int t, int j, float v) { RB(1)[t * LDW + j] = f2bf(v + bf2f(RB(13)[t * LDW + j])); });
    __syncthreads();
    { float* QTu = Gp.QT + (size_t)uidx * 4096;
      mm64(RB(0), RB(6), wid, lane, [&](int k2, int vv, float v) { QTu[(((vv >> 4) * 4 + (k2 >> 4)) * 64 + ((k2 >> 2) & 3) * 16 + (vv & 15)) * 4 + (k2 & 3)] = v; }); }
    { bf16_t* YLu = Gp.YL + (size_t)uidx * 4096;
      mm64(RB(1), RB(6), wid, lane, [&](int t, int vv, float v) { YLu[t * 64 + vv] = f2bf(v); }); }
    __syncthreads();
#undef RB
}
__device__ __forceinline__ void rwkv_scan_wave(const RwkvG& Gp, int b, int h, int sl, int lane) {
    bf16x8 sB[2];
#pragma unroll
    for (int s = 0; s < 2; ++s)
#pragma unroll
        for (int j = 0; j < 8; ++j) sB[s][j] = 0;
    const int q = lane >> 4, vv = 16 * sl + (lane & 15);
    bf16x8 pa[4][2]; f32x4 qa[4];
    { const int uidx = (b * 128 + 0) * 4 + h; const bf16_t* PTu = Gp.PT + (size_t)uidx * 4096; const float* QTu = Gp.QT + (size_t)uidx * 4096;
#pragma unroll
      for (int r2 = 0; r2 < 4; ++r2) { pa[r2][0] = *(const bf16x8*)(PTu + ((r2 * 2 + 0) * 64 + lane) * 8); pa[r2][1] = *(const bf16x8*)(PTu + ((r2 * 2 + 1) * 64 + lane) * 8); qa[r2] = *(const f32x4*)(QTu + ((sl * 4 + r2) * 64 + lane) * 4); } }
    for (int c = 0; c < 128; ++c) {
        const int uidx = (b * 128 + c) * 4 + h;
        { bf16_t* S0u = Gp.S0 + (size_t)uidx * 4096 + vv * 64;
#pragma unroll
          for (int s = 0; s < 2; ++s)
#pragma unroll
              for (int jh = 0; jh < 2; ++jh) { u32x2 w; const u32x4 sw = __builtin_bit_cast(u32x4, sB[s]); w[0] = sw[2 * jh]; w[1] = sw[2 * jh + 1]; *(u32x2*)(S0u + 16 * (2 * s + jh) + 4 * q) = w; } }
        bf16x8 pn[4][2]; f32x4 qn[4];
        { const int cn = c < 127 ? c + 1 : c; const int un = (b * 128 + cn) * 4 + h; const bf16_t* PTu = Gp.PT + (size_t)un * 4096; const float* QTu = Gp.QT + (size_t)un * 4096;
#pragma unroll
          for (int r2 = 0; r2 < 4; ++r2) { pn[r2][0] = *(const bf16x8*)(PTu + ((r2 * 2 + 0) * 64 + lane) * 8); pn[r2][1] = *(const bf16x8*)(PTu + ((r2 * 2 + 1) * 64 + lane) * 8); qn[r2] = *(const f32x4*)(QTu + ((sl * 4 + r2) * 64 + lane) * 4); } }
        f32x4 acc[4];
#pragma unroll
        for (int r2 = 0; r2 < 4; ++r2) { acc[r2] = MFMA16(pa[r2][0], sB[0], qa[r2]); acc[r2] = MFMA16(pa[r2][1], sB[1], acc[r2]); }
#pragma unroll
        for (int s = 0; s < 2; ++s) { u32x4 p; p[0] = pk2(acc[2 * s][0], acc[2 * s][1]); p[1] = pk2(acc[2 * s][2], acc[2 * s][3]); p[2] = pk2(acc[2 * s + 1][0], acc[2 * s + 1][1]); p[3] = pk2(acc[2 * s + 1][2], acc[2 * s + 1][3]); sB[s] = __builtin_bit_cast(bf16x8, p); }
#pragma unroll
        for (int r2 = 0; r2 < 4; ++r2) { pa[r2][0] = pn[r2][0]; pa[r2][1] = pn[r2][1]; qa[r2] = qn[r2]; }
    }
}
__device__ __forceinline__ void rwkv_fix_unit(LAS unsigned char* lds, const bf16_t* __restrict__ projn, const RwkvW& W, const RwkvG& Gp, bf16_t* __restrict__ mix, int b, int c, int h) {
    const int tid = threadIdx.x, wid = tid >> 6, lane = tid & 63;
    const size_t tok0 = (size_t)b * SEQ + (size_t)c * 64; const int uidx = (b * 128 + c) * 4 + h;
    LAS bf16_t* Xg = (LAS bf16_t*)lds; LAS bf16_t* Ys = (LAS bf16_t*)(lds + RBUF); LAS float* YF = (LAS float*)(lds + 2 * RBUF);
    { const int row = tid >> 3, cc = (tid & 7) * 8;
      *(LAS u32x4*)(Xg + row * LDW + cc) = *(const u32x4*)(Gp.GT + (size_t)uidx * 4096 + row * 64 + cc);
      *(LAS u32x4*)(Ys + row * LDW + cc) = *(const u32x4*)(Gp.S0 + (size_t)uidx * 4096 + row * 64 + cc); }
    __syncthreads();
    { const bf16_t* YLu = Gp.YL + (size_t)uidx * 4096;
      mm64(Xg, Ys, wid, lane, [&](int t, int vv, float v) { YF[t * 65 + vv] = v + bf2f(YLu[t * 64 + vv]); }); }
    __syncthreads();
    { const int t = tid >> 3, vg = tid & 7, col0 = h * 64 + vg * 8; const bool hasprev = !(c == 0 && t == 0);
      float y[8]; float s = 0.f;
#pragma unroll
      for (int i = 0; i < 8; ++i) { y[i] = YF[t * 65 + vg * 8 + i]; s += y[i]; }
      s += __shfl_xor(s, 1, 64); s += __shfl_xor(s, 2, 64); s += __shfl_xor(s, 4, 64);
      const float mu = s * (1.0f / 64.0f); float qv = 0.f;
#pragma unroll
      for (int i = 0; i < 8; ++i) { const float d = y[i] - mu; qv += d * d; }
      qv += __shfl_xor(qv, 1, 64); qv += __shfl_xor(qv, 2, 64); qv += __shfl_xor(qv, 4, 64);
      const float rs = rsqrtf(qv * (1.0f / 64.0f) + 64e-5f);
      float v[8]; shifted8(projn + (tok0 + t) * PN + C_PB + 512 + col0, hasprev, W.shift_mu + 512 + col0, v);
      const u32x4 gw = *(const u32x4*)(Gp.G + (tok0 + t) * 256 + col0); const float bon = Gp.BON[(tok0 + t) * 4 + h];
      float o[8];
#pragma unroll
      for (int i = 0; i < 8; ++i) { const float g = (i & 1) ? bfhi(gw[i >> 1]) : bflo(gw[i >> 1]); o[i] = ((y[i] - mu) * rs * W.lnx_g[col0 + i] + W.lnx_b[col0 + i] + bon * v[i]) * g; }
      *(bf16x8*)(mix + (tok0 + t) * D + 384 + col0) = pack8f(o); }
    __syncthreads();
}
__global__ void __launch_bounds__(NTHR, 2) k_rwkv_prep2(const bf16_t* projn, RwkvW W, RwkvG Gp) {
    extern __shared__ __attribute__((aligned(16))) unsigned char shm[];
    for (int u = blockIdx.x; u < 1024; u += gridDim.x) rwkv_prep_unit((LAS unsigned char*)shm, projn, W, Gp, u >> 9, (u >> 2) & 127, u & 3);
}
__global__ void __launch_bounds__(NTHR, 2) k_rwkv_scan2(RwkvG Gp) {
    const int wid = threadIdx.x >> 6; if (wid < 4) rwkv_scan_wave(Gp, blockIdx.x >> 2, blockIdx.x & 3, wid, threadIdx.x & 63);
}
__global__ void __launch_bounds__(NTHR, 2) k_rwkv_fix2(const bf16_t* projn, RwkvW W, RwkvG Gp, bf16_t* mix) {
    extern __shared__ __attribute__((aligned(16))) unsigned char shm[];
    for (int u = blockIdx.x; u < 1024; u += gridDim.x) rwkv_fix_unit((LAS unsigned char*)shm, projn, W, Gp, mix, u >> 9, (u >> 2) & 127, u & 3);
}

constexpr int LIST_CAP = 16384;
struct MoeBuf { int* cnt; int* list_tok; float* list_w; };
__device__ __forceinline__ float max3f(float a, float b, float c) { return fmaxf(a, fmaxf(b, c)); }
__device__ __forceinline__ void ln1_route_unit(LAS unsigned char* lds, const bf16_t* __restrict__ Y1, const float* __restrict__ g, const float* __restrict__ bta, bf16_t* __restrict__ H1,
                                               const float* __restrict__ router_w, const float* __restrict__ router_bias, const MoeBuf& mb, int unit, bool load_rw) {
    LAS float* rwT = (LAS float*)lds;
    LAS int* tokE = (LAS int*)(lds + 65536);
    LAS float* tokW = (LAS float*)(lds + 65536 + 512);
    LAS int* ebase = (LAS int*)(lds + 65536 + 1024);
    const int tid = threadIdx.x, wid = tid >> 6, lane = tid & 63;
    if (load_rw) { for (int i = tid; i < 16384; i += NTHR) rwT[(i & 15) * 1024 + (i >> 4)] = router_w[i]; }
    __syncthreads();
    for (int tt = 0; tt < 8; ++tt) {
        const int tl = wid * 8 + tt; const size_t t = (size_t)unit * 64 + tl;
        float v[16];
#pragma unroll
        for (int i = 0; i < 4; ++i) { const u32x2 a = *(const u32x2*)(Y1 + t * D + lane * 4 + 256 * i); v[4 * i] = bflo(a[0]); v[4 * i + 1] = bfhi(a[0]); v[4 * i + 2] = bflo(a[1]); v[4 * i + 3] = bfhi(a[1]); }
        float s = 0.f;
#pragma unroll
        for (int i = 0; i < 16; ++i) s += v[i];
        const float mu = wave_sum(s) * (1.0f / D); float q = 0.f;
#pragma unroll
        for (int i = 0; i < 16; ++i) { const float d = v[i] - mu; q += d * d; }
        const float rs = rsqrtf(wave_sum(q) * (1.0f / D) + 1e-5f);
#pragma unroll
        for (int i = 0; i < 4; ++i) { const int col = lane * 4 + 256 * i; const f32x4 gv = *(const f32x4*)(g + col), bv = *(const f32x4*)(bta + col);
#pragma unroll
            for (int j = 0; j < 4; ++j) v[4 * i + j] = (v[4 * i + j] - mu) * rs * gv[j] + bv[j];
            u32x2 w; w[0] = pk2(v[4 * i], v[4 * i + 1]); w[1] = pk2(v[4 * i + 2], v[4 * i + 3]); *(u32x2*)(H1 + t * D + col) = w; }
        float sc[16], sl[16];
#pragma unroll
        for (int e = 0; e < 16; ++e) { float a = 0.f;
#pragma unroll
            for (int i = 0; i < 4; ++i) { const f32x4 r = *(const LAS f32x4*)(rwT + e * 1024 + lane * 4 + 256 * i); a += v[4 * i] * r[0] + v[4 * i + 1] * r[1] + v[4 * i + 2] * r[2] + v[4 * i + 3] * r[3]; }
            a = wave_sum(a); sc[e] = sigmoidf_(a); sl[e] = sc[e] + router_bias[e]; }
        float gs[4];
#pragma unroll
        for (int gI = 0; gI < 4; ++gI) { const float a = sl[4 * gI], b = sl[4 * gI + 1], c = sl[4 * gI + 2], d = sl[4 * gI + 3]; gs[gI] = fmaxf(max3f(a + b, a + c, a + d), max3f(b + c, b + d, c + d)); }
        int bg = 0; float best = gs[0];
#pragma unroll
        for (int gI = 1; gI < 4; ++gI) if (gs[gI] > best) { best = gs[gI]; bg = gI; }
        float xs[4], xc[4];
#pragma unroll
        for (int i = 0; i < 4; ++i) { xs[i] = bg == 0 ? sl[i] : (bg == 1 ? sl[4 + i] : (bg == 2 ? sl[8 + i] : sl[12 + i])); xc[i] = bg == 0 ? sc[i] : (bg == 1 ? sc[4 + i] : (bg == 2 ? sc[8 + i] : sc[12 + i])); }
        int i1 = 0; float m1 = xs[0];
#pragma unroll
        for (int i = 1; i < 4; ++i) if (xs[i] > m1) { m1 = xs[i]; i1 = i; }
        int i2 = -1; float m2 = -INFINITY;
#pragma unroll
        for (int i = 0; i < 4; ++i) if (i != i1 && xs[i] > m2) { m2 = xs[i]; i2 = i; }
        const float w1 = i1 == 0 ? xc[0] : (i1 == 1 ? xc[1] : (i1 == 2 ? xc[2] : xc[3])), w2 = i2 == 0 ? xc[0] : (i2 == 1 ? xc[1] : (i2 == 2 ? xc[2] : xc[3]));
        const float inv = 1.0f / (w1 + w2);
        if (lane == 0) { tokE[tl * 2] = bg * 4 + i1; tokE[tl * 2 + 1] = bg * 4 + i2; tokW[tl * 2] = w1 * inv; tokW[tl * 2 + 1] = w2 * inv; }
    }
    __syncthreads();
    if (tid < 16) { int n = 0; for (int i = 0; i < 128; ++i) n += (tokE[i] == tid) ? 1 : 0; ebase[tid] = n ? atomicAdd(mb.cnt + tid, n) : 0; }
    __syncthreads();
    if (tid < 128) { const int e = tokE[tid]; int rank = 0; for (int i = 0; i < tid; ++i) rank += (tokE[i] == e) ? 1 : 0; const int p = ebase[e] + rank;
        mb.list_tok[e * LIST_CAP + p] = (unit * 64 + (tid >> 1)) * 2 + (tid & 1); mb.list_w[e * LIST_CAP + p] = tokW[tid]; }
    __syncthreads();
}
__global__ void __launch_bounds__(NTHR, 2) k_ln1_route(const bf16_t* Y1, const float* g, const float* b, bf16_t* H1, const float* router_w, const float* router_bias, MoeBuf mb) {
    extern __shared__ __attribute__((aligned(16))) unsigned char shm[];
    bool first = true;
    for (int u = blockIdx.x; u < 256; u += gridDim.x) { ln1_route_unit((LAS unsigned char*)shm, Y1, g, b, H1, router_w, router_bias, mb, u, first); first = false; }
}
struct ExpSel { int e, ti_in, n; };
__device__ __forceinline__ ExpSel find_expert(const int (&cnt)[16], int ti) {
    ExpSel r; r.e = -1; r.ti_in = 0; r.n = 0; int rem = ti;
#pragma unroll
    for (int e = 0; e < 16; ++e) { const int te = (cnt[e] + 255) >> 8; const bool hit = (r.e < 0) && (rem < te); if (hit) { r.e = e; r.ti_in = rem; r.n = cnt[e]; } if (r.e < 0) rem -= te; }
    return r;
}
struct SchedMoe1 {
    const char* H1; const char* W1; const int* list_tok; int cnt[16]; int G, c;
    __device__ __forceinline__ bool next(int i, pg8::Unit& u) const {
        const int L = i * G + c, ti = L >> 1, ct = L & 1; const ExpSel x = find_expert(cnt, ti); if (x.e < 0) return false;
        u.a = H1; u.b = W1 + ((size_t)x.e * 512 + ct * 256) * 2048; u.row0 = ti * 256; u.col0 = ct * 128; u.kind = x.e; u.aux = x.ti_in * 256; u.n = x.n; return true;
    }
    __device__ __forceinline__ unsigned a_off(const pg8::Unit& u, int r) const { const int p = u.aux + r; const int ent = p < u.n ? list_tok[u.kind * LIST_CAP + p] : 0; return (unsigned)(ent >> 1) * 2048u; }
};
struct EpiMoe1 {
    static constexpr bool PERM = true;
    const float* list_w; bf16_t* ACT;
    __device__ __forceinline__ void operator()(const f32x4 (&acc)[2][2][4][2], const pg8::Unit& u, int wr, int wc, int fr, int fq) const {
#pragma unroll
        for (int ai = 0; ai < 2; ++ai)
#pragma unroll
            for (int m = 0; m < 4; ++m) { const int r = ai * 128 + wr * 64 + m * 16 + fr, p = u.aux + r; const float w = p < u.n ? list_w[u.kind * LIST_CAP + p] : 0.f;
                float o[8];
#pragma unroll
                for (int n = 0; n < 2; ++n)
#pragma unroll
                    for (int j = 0; j < 4; ++j) { const float gq = acc[ai][0][m][n][j], uq = acc[ai][1][m][n][j]; o[4 * n + j] = gq / (1.0f + __expf(-gq)) * uq * w; }
                *(bf16x8*)(ACT + (size_t)(u.row0 + r) * 256 + u.col0 + wc * 32 + 8 * fq) = pack8f(o); }
    }
};
struct SchedMoe2 {
    const char* ACT; const char* WD; int cnt[16]; int G, c;
    __device__ __forceinline__ bool next(int i, pg8::Unit& u) const {
        const int L = i * G + c, ti = L >> 2, ct = L & 3; const ExpSel x = find_expert(cnt, ti); if (x.e < 0) return false;
        u.a = ACT + (size_t)ti * 256 * 512; u.b = WD + ((size_t)x.e * 1024 + ct * 256) * 512; u.row0 = x.ti_in * 256; u.col0 = ct * 256; u.kind = x.e; u.aux = 0; u.n = x.n; return true;
    }
};
struct EpiMoe2 {
    static constexpr bool PERM = true;
    const int* list_tok; bf16_t* F;
    __device__ __forceinline__ void operator()(const f32x4 (&acc)[2][2][4][2], const pg8::Unit& u, int wr, int wc, int fr, int fq) const {
        const unsigned colb = (unsigned)(u.col0 + wc * 32 + 8 * fq) * 2u; const int pbase = u.row0 + wr * 64 + fr; const int* lt = list_tok + u.kind * LIST_CAP;
#pragma unroll
        for (int ai = 0; ai < 2; ++ai)
#pragma unroll
            for (int m = 0; m < 4; ++m) { const int p = pbase + ai * 128 + m * 16;
                if (p < u.n) { const int ent = lt[p]; char* rowp = (char*)F + ((unsigned)((ent & 1) * NTOK + (ent >> 1)) * 2048u + colb);
#pragma unroll
                    for (int bj = 0; bj < 2; ++bj) { const f32x4 v0 = acc[ai][bj][m][0], v1 = acc[ai][bj][m][1]; u32x4 w;
                        w[0] = pk2(v0[0], v0[1]); w[1] = pk2(v0[2], v0[3]); w[2] = pk2(v1[0], v1[1]); w[3] = pk2(v1[2], v1[3]); *(u32x4*)(rowp + bj * 256) = w; } }
                asm volatile("" ::: "memory"); }
    }
};
__global__ void __launch_bounds__(NTHR, 2) k_moe1(const bf16_t* H1, const bf16_t* W1_T, MoeBuf mb, bf16_t* ACT) {
    extern __shared__ __attribute__((aligned(16))) unsigned char shm[];
    SchedMoe1 S; S.H1 = (const char*)H1; S.W1 = (const char*)W1_T; S.list_tok = mb.list_tok; S.G = (int)gridDim.x; S.c = (int)blockIdx.x;
#pragma unroll
    for (int e = 0; e < 16; ++e) S.cnt[e] = mb.cnt[e];
    EpiMoe1 E{mb.list_w, ACT};
    pg8::gemm_phase<EpiMoe1, SchedMoe1, true>((LAS unsigned char*)shm, 1024, S, E);
}
__global__ void __launch_bounds__(NTHR, 2) k_moe2(const bf16_t* ACT, const bf16_t* WD_T, MoeBuf mb, bf16_t* F) {
    extern __shared__ __attribute__((aligned(16))) unsigned char shm[];
    SchedMoe2 S; S.ACT = (const char*)ACT; S.WD = (const char*)WD_T; S.G = (int)gridDim.x; S.c = (int)blockIdx.x;
#pragma unroll
    for (int e = 0; e < 16; ++e) S.cnt[e] = mb.cnt[e];
    EpiMoe2 E{mb.list_tok, F};
    pg8::gemm_phase<EpiMoe2, SchedMoe2, false>((LAS unsigned char*)shm, 256, S, E);
}
__global__ void __launch_bounds__(NTHR, 2) k_ln2b(const bf16_t* __restrict__ H1, const bf16_t* __restrict__ F, const float* __restrict__ g, const float* __restrict__ b, bf16_t* Hout, float* Fout) {
    const int lane = threadIdx.x & 63, wv = threadIdx.x >> 6;
    for (int t = blockIdx.x * 8 + wv; t < NTOK; t += gridDim.x * 8) {
        float v[16];
#pragma unroll
        for (int i = 0; i < 4; ++i) { const size_t o = (size_t)t * D + lane * 4 + 256 * i; const u32x2 a = *(const u32x2*)(H1 + o), f0 = *(const u32x2*)(F + o), f1 = *(const u32x2*)(F + (size_t)NTOK * D + o);
            v[4 * i] = ALPHA * bflo(a[0]) + bflo(f0[0]) + bflo(f1[0]); v[4 * i + 1] = ALPHA * bfhi(a[0]) + bfhi(f0[0]) + bfhi(f1[0]);
            v[4 * i + 2] = ALPHA * bflo(a[1]) + bflo(f0[1]) + bflo(f1[1]); v[4 * i + 3] = ALPHA * bfhi(a[1]) + bfhi(f0[1]) + bfhi(f1[1]); }
        ln_finish_store(v, g, b, lane, Hout ? Hout + (size_t)t * D : nullptr, Fout ? Fout + (size_t)t * D : nullptr);
    }
}

struct RwkvP { const float *shift_mu, *decay_w0, *decay_up, *iclr_a0, *iclr_up, *gate_up, *k_k, *k_a, *r_k, *lnx_g, *lnx_b; };
__global__ void __launch_bounds__(256) k_rwkv_prep(const bf16_t* __restrict__ projn, int tok0, RwkvP P,
                                                   float* __restrict__ R, float* __restrict__ Wd, float* __restrict__ Kk, float* __restrict__ V,
                                                   float* __restrict__ Aa, float* __restrict__ Bb, float* __restrict__ G, float* __restrict__ BON) {
    __shared__ float p[1024];
    const int tl = blockIdx.x, c = threadIdx.x; const size_t t = (size_t)tok0 + tl;
    const bf16_t* pr = projn + t * PN + C_PB;
#pragma unroll
    for (int i = 0; i < 4; ++i) { const int col = c + 256 * i; const float cur = bf2f(pr[col]); const float prv = tl > 0 ? bf2f(pr[col - PN]) : 0.f; p[col] = cur + (prv - cur) * P.shift_mu[col]; }
    __syncthreads();
    const float r = p[c], k = p[256 + c], v = p[512 + c];
    float u = P.decay_w0[c], a = P.iclr_a0[c], g = 0.f;
    for (int j = 0; j < 64; ++j) { u += tanhf(p[768 + j]) * P.decay_up[j * 256 + c]; a += p[832 + j] * P.iclr_up[j * 256 + c]; }
    for (int j = 0; j < 128; ++j) g += sigmoidf_(p[896 + j]) * P.gate_up[j * 256 + c];
    a = sigmoidf_(a);
    const float w = __expf(-0.6065306597f * sigmoidf_(u));
    const float kk = k * P.k_k[c];
    const float ss = wave_sum(kk * kk);
    const float kkn = kk * rsqrtf(fmaxf(ss, 1e-24f));
    const float kmod = k * (1.0f + (a - 1.0f) * P.k_a[c]);
    const float bon = wave_sum(r * kmod * P.r_k[c]);
    const size_t o = (size_t)tl * 256 + c;
    R[o] = r; Wd[o] = w; Kk[o] = kmod; V[o] = v; Aa[o] = -kkn; Bb[o] = kkn * a; G[o] = g;
    if ((c & 63) == 0) BON[tl * 4 + (c >> 6)] = bon;
}
__global__ void __launch_bounds__(64) k_rwkv_scan(const float* __restrict__ R, const float* __restrict__ Wd, const float* __restrict__ Kk, const float* __restrict__ V,
                                                  const float* __restrict__ Aa, const float* __restrict__ Bb, float* __restrict__ Y) {
    const int h = blockIdx.x, lane = threadIdx.x;
    float S[64];
#pragma unroll
    for (int j = 0; j < 64; ++j) S[j] = 0.f;
    for (int t = 0; t < SEQ; ++t) {
        const size_t o = (size_t)t * 256 + h * 64;
        const float vv = V[o + lane];
        float sa = 0.f;
#pragma unroll
        for (int j = 0; j < 64; ++j) sa += S[j] * Aa[o + j];
        float y = 0.f;
#pragma unroll
        for (int j = 0; j < 64; ++j) { S[j] = S[j] * Wd[o + j] + sa * Bb[o + j] + vv * Kk[o + j]; y += S[j] * R[o + j]; }
        Y[o + lane] = y;
    }
}
__global__ void __launch_bounds__(256) k_rwkv_out(const float* __restrict__ Y, const float* __restrict__ V, const float* __restrict__ G, const float* __restrict__ BON,
                                                  RwkvP P, int tok0, bf16_t* __restrict__ mix) {
    const int tl = blockIdx.x, c = threadIdx.x; const size_t o = (size_t)tl * 256 + c;
    const float y = Y[o];
    const float mu = wave_sum(y) * (1.0f / 64.0f);
    const float d = y - mu;
    const float var = wave_sum(d * d) * (1.0f / 64.0f);
    const float yn = d * rsqrtf(var + 64e-5f) * P.lnx_g[c] + P.lnx_b[c];
    const float out = (yn + BON[tl * 4 + (c >> 6)] * V[o]) * G[o];
    mix[((size_t)tok0 + tl) * D + 384 + c] = f2bf(out);
}
__global__ void __launch_bounds__(256) k_moe_naive(const bf16_t* __restrict__ H1, const float* __restrict__ router_w, const float* __restrict__ router_bias,
                                                   const float* __restrict__ w_gate, const float* __restrict__ w_up, const float* __restrict__ w_down, float* __restrict__ F) {
    __shared__ float x[1024]; __shared__ float part[16][16]; __shared__ float sc[16]; __shared__ float act[256];
    __shared__ int sel_e[2]; __shared__ float sel_w[2]; __shared__ float sl[16];
    const int t = blockIdx.x, tid = threadIdx.x;
#pragma unroll
    for (int i = 0; i < 4; ++i) x[tid + 256 * i] = bf2f(H1[(size_t)t * D + tid + 256 * i]);
    __syncthreads();
    { const int e = tid & 15, pt = tid >> 4; float s = 0.f; for (int d = pt * 64; d < pt * 64 + 64; ++d) s += x[d] * router_w[d * 16 + e]; part[pt][e] = s; }
    __syncthreads();
    if (tid < 16) { float s = 0.f; for (int i = 0; i < 16; ++i) s += part[i][tid]; sc[tid] = sigmoidf_(s); sl[tid] = sc[tid] + router_bias[tid]; }
    __syncthreads();
    if (tid == 0) {
        int bg = 0; float bs = -INFINITY;
        for (int g = 0; g < 4; ++g) { float m1 = -INFINITY, m2 = -INFINITY; for (int i = 0; i < 4; ++i) { const float v = sl[g * 4 + i]; if (v > m1) { m2 = m1; m1 = v; } else if (v > m2) m2 = v; }
            const float gs = m1 + m2; if (gs > bs) { bs = gs; bg = g; } }
        int i1 = -1, i2 = -1; float m1 = -INFINITY, m2 = -INFINITY;
        for (int i = 0; i < 4; ++i) { const float v = sl[bg * 4 + i]; if (v > m1) { m2 = m1; i2 = i1; m1 = v; i1 = i; } else if (v > m2) { m2 = v; i2 = i; } }
        const int e1 = bg * 4 + i1, e2 = bg * 4 + i2; const float w1 = sc[e1], w2 = sc[e2], inv = 1.0f / (w1 + w2);
        sel_e[0] = e1; sel_e[1] = e2; sel_w[0] = w1 * inv; sel_w[1] = w2 * inv;
    }
    __syncthreads();
    float y[4] = {0.f, 0.f, 0.f, 0.f};
    for (int s = 0; s < 2; ++s) {
        const int e = sel_e[s]; const float gw = sel_w[s];
        const float* wg = w_gate + (size_t)e * 1024 * 256; const float* wu = w_up + (size_t)e * 1024 * 256; const float* wd = w_down + (size_t)e * 256 * 1024;
        float hg = 0.f, hu = 0.f;
        for (int d = 0; d < 1024; ++d) { const float xv = x[d]; hg += xv * wg[d * 256 + tid]; hu += xv * wu[d * 256 + tid]; }
        __syncthreads();
        act[tid] = hg * sigmoidf_(hg) * hu * gw;
        __syncthreads();
        for (int f = 0; f < 256; ++f) { const float a = act[f];
#pragma unroll
            for (int i = 0; i < 4; ++i) y[i] += a * wd[(size_t)f * 1024 + tid + 256 * i]; }
    }
#pragma unroll
    for (int i = 0; i < 4; ++i) F[(size_t)t * D + tid + 256 * i] = y[i];
}

extern "C" void kernel_launch(void* const* d_in, const int* in_sizes, int n_in, void* d_out, int out_size, void* d_ws, size_t ws_size, hipStream_t stream) {
    const float* x = (const float*)d_in[0];
    const float* ln0_g = (const float*)d_in[1]; const float* ln0_b = (const float*)d_in[2];
    const float* w_in = (const float*)d_in[3]; const float* w_out = (const float*)d_in[4];
    const float* sinks = (const float*)d_in[5]; const float* rel_bias = (const float*)d_in[6];
    const float* shift_mu = (const float*)d_in[7]; const float* decay_w0 = (const float*)d_in[8]; const float* decay_up = (const float*)d_in[9];
    const float* iclr_a0 = (const float*)d_in[10]; const float* iclr_up = (const float*)d_in[11]; const float* gate_up = (const float*)d_in[12];
    const float* k_k = (const float*)d_in[13]; const float* k_a = (const float*)d_in[14]; const float* r_k = (const float*)d_in[15];
    const float* lnx_g = (const float*)d_in[16]; const float* lnx_b = (const float*)d_in[17];
    const float* ln1_g = (const float*)d_in[18]; const float* ln1_b = (const float*)d_in[19];
    const float* router_w = (const float*)d_in[20]; const float* router_bias = (const float*)d_in[21];
    const float* w_gate = (const float*)d_in[22]; const float* w_up = (const float*)d_in[23]; const float* w_down = (const float*)d_in[24];
    const float* ln2_g = (const float*)d_in[25]; const float* ln2_b = (const float*)d_in[26];

    const size_t MiB = 1048576;
    char* ws = (char*)d_ws;
    bf16_t* H = (bf16_t*)(ws);
    bf16_t* PROJN = (bf16_t*)(ws + 32 * MiB);
    bf16_t* VT = (bf16_t*)(ws + 104 * MiB);
    bf16_t* MIX = (bf16_t*)(ws + 120 * MiB);
    float* RW = (float*)(ws + 152 * MiB);
    bf16_t* Wb = (bf16_t*)(ws + 220 * MiB);
    bf16_t* Y1 = (bf16_t*)(ws + 32 * MiB);
    bf16_t* H1 = (bf16_t*)(ws + 64 * MiB);
    bf16_t* Fb = (bf16_t*)(ws + 120 * MiB);
    bf16_t* ACT = (bf16_t*)(ws + 96 * MiB);
    char* MISC = ws + 252 * MiB;
    MoeBuf mb{(int*)MISC, (int*)(MISC + 4096), (float*)(MISC + 4096 + (size_t)16 * LIST_CAP * 4)};
    bf16_t* WIN_T = Wb; bf16_t* WOUT_T = Wb + (size_t)2816 * 1024; bf16_t* W1_T = WOUT_T + (size_t)1024 * 1024; bf16_t* WD_T = W1_T + (size_t)16 * 512 * 1024;
    bf16_t* DUP_T = WD_T + (size_t)16 * 1024 * 256; bf16_t* IUP_T = DUP_T + 256 * 64; bf16_t* GUP_T = IUP_T + 256 * 64;
    char* RWG = ws + 152 * MiB;
    RwkvG Gp{(bf16_t*)(RWG + RWG_PT), (float*)(RWG + RWG_QT), (bf16_t*)(RWG + RWG_GT), (bf16_t*)(RWG + RWG_YL), (bf16_t*)(RWG + RWG_S0), (bf16_t*)(RWG + RWG_G), (float*)(RWG + RWG_BON)};
    const size_t RA = (size_t)SEQ * 256;
    float *rR = RW, *rW = RW + RA, *rK = RW + 2 * RA, *rV = RW + 3 * RA, *rA = RW + 4 * RA, *rB = RW + 5 * RA, *rG = RW + 6 * RA, *rY = RW + 7 * RA, *rBON = RW + 8 * RA;

    static bool attr_done = false;
    if (!attr_done) {
        hipFuncSetAttribute((const void*)k_proj, hipFuncAttributeMaxDynamicSharedMemorySize, pg8::STAGE_BYTES);
        hipFuncSetAttribute((const void*)k_wout, hipFuncAttributeMaxDynamicSharedMemorySize, pg8::STAGE_BYTES);
        hipFuncSetAttribute((const void*)k_rwkv_prep2, hipFuncAttributeMaxDynamicSharedMemorySize, RW_LDS);
        hipFuncSetAttribute((const void*)k_ln1_route, hipFuncAttributeMaxDynamicSharedMemorySize, 65536 + 2048);
        hipFuncSetAttribute((const void*)k_moe1, hipFuncAttributeMaxDynamicSharedMemorySize, pg8::STAGE_BYTES);
        hipFuncSetAttribute((const void*)k_moe2, hipFuncAttributeMaxDynamicSharedMemorySize, pg8::STAGE_BYTES);
        hipFuncSetAttribute((const void*)k_rwkv_fix2, hipFuncAttributeMaxDynamicSharedMemorySize, RW_LDS);
        attr_done = true;
    }
    const int G = 256;
    k_ln0<<<G, NTHR, 0, stream>>>(x, ln0_g, ln0_b, H);
    for (int l = 0; l < 2; ++l) {
        ConvP cp{w_in + (size_t)l * D * INC, w_out + (size_t)l * D * D, w_gate + (size_t)l * 16 * 1024 * 256, w_up + (size_t)l * 16 * 1024 * 256, w_down + (size_t)l * 16 * 256 * 1024, decay_up + (size_t)l * 64 * 256, iclr_up + (size_t)l * 64 * 256, gate_up + (size_t)l * 128 * 256, WIN_T, WOUT_T, W1_T, WD_T, DUP_T, IUP_T, GUP_T};
        k_convert<<<G, NTHR, 0, stream>>>(cp);
        k_proj<<<G, NTHR, pg8::STAGE_BYTES, stream>>>(H, WIN_T, PROJN, VT);
        k_attn<<<G, NTHR, 4096, stream>>>(PROJN, VT, sinks + l * 6, rel_bias, MIX);
        RwkvP P{shift_mu + l * 1024, decay_w0 + l * 256, decay_up + (size_t)l * 64 * 256, iclr_a0 + l * 256, iclr_up + (size_t)l * 64 * 256, gate_up + (size_t)l * 128 * 256,
                k_k + l * 256, k_a + l * 256, r_k + l * 256, lnx_g + l * 256, lnx_b + l * 256};
        RwkvW Wr{shift_mu + l * 1024, decay_w0 + l * 256, iclr_a0 + l * 256, k_k + l * 256, k_a + l * 256, r_k + l * 256, lnx_g + l * 256, lnx_b + l * 256, DUP_T, IUP_T, GUP_T};
        k_rwkv_prep2<<<G, NTHR, RW_LDS, stream>>>(PROJN, Wr, Gp);
        k_rwkv_scan2<<<8, NTHR, 0, stream>>>(Gp);
        k_rwkv_fix2<<<G, NTHR, RW_LDS, stream>>>(PROJN, Wr, Gp, MIX);
        k_wout<<<G, NTHR, pg8::STAGE_BYTES, stream>>>(MIX, WOUT_T, H, Y1);
        hipMemsetAsync(mb.cnt, 0, 64, stream);
        k_ln1_route<<<G, NTHR, 65536 + 2048, stream>>>(Y1, ln1_g + l * D, ln1_b + l * D, H1, router_w, router_bias, mb);
        k_moe1<<<G, NTHR, pg8::STAGE_BYTES, stream>>>(H1, W1_T, mb, ACT);
        k_moe2<<<G, NTHR, pg8::STAGE_BYTES, stream>>>(ACT, WD_T, mb, Fb);
        k_ln2b<<<G, NTHR, 0, stream>>>(H1, Fb, ln2_g + l * D, ln2_b + l * D, l == 1 ? nullptr : H, l == 1 ? (float*)d_out : nullptr);
    }
}
```

```cpp
#include <hip/hip_runtime.h>
#include <stdint.h>
#include <cstdio>

typedef unsigned short bf16_t;
typedef short bf16x8 __attribute__((ext_vector_type(8)));
typedef float f32x4 __attribute__((ext_vector_type(4)));
typedef float f32x2 __attribute__((ext_vector_type(2)));
typedef float f32x16 __attribute__((ext_vector_type(16)));
typedef unsigned u32x4 __attribute__((ext_vector_type(4)));
typedef unsigned u32x2 __attribute__((ext_vector_type(2)));
#define LAS __attribute__((address_space(3)))

__device__ __forceinline__ bf16_t f2bf(float f) { unsigned u = __float_as_uint(f); u += 0x7FFFu + ((u >> 16) & 1u); return (bf16_t)(u >> 16); }
__device__ __forceinline__ float bf2f(bf16_t b) { return __uint_as_float(((unsigned)b) << 16); }
typedef __bf16 bf16v2_t __attribute__((ext_vector_type(2)));
__device__ __forceinline__ unsigned pk2(float lo, float hi) { f32x2 f = {lo, hi}; bf16v2_t b = __builtin_convertvector(f, bf16v2_t); return __builtin_bit_cast(unsigned, b); }
__device__ __forceinline__ float bflo(unsigned w) { return __uint_as_float(w << 16); }
__device__ __forceinline__ float bfhi(unsigned w) { return __uint_as_float(w & 0xFFFF0000u); }

__device__ __forceinline__ int ltid() { int t = (int)__builtin_amdgcn_workitem_id_x(); asm volatile("" : "+v"(t)); return t; }
__device__ __forceinline__ int lbid() { int b = (int)__builtin_amdgcn_workgroup_id_x(); asm volatile("" : "+s"(b)); return b; }
constexpr int D = 1024, SEQ = 8192, NTOK = 16384, INC = 2816;
constexpr int PN = 2304;
constexpr int C_QA = 0, C_KA = 384, C_PB = 512, C_QC = 1536, C_KC = 1920;
constexpr int VT_LD = NTOK;
constexpr float ALPHA = 1.41421356237f;
constexpr int NTHR = 512;

struct MegaP {
    const float *x, *ln0_g, *ln0_b, *w_in, *w_out, *sinks, *rel_bias, *shift_mu, *decay_w0, *decay_up, *iclr_a0, *iclr_up, *gate_up, *k_k, *k_a, *r_k, *lnx_g, *lnx_b,
                *ln1_g, *ln1_b, *router_w, *router_bias, *w_gate, *w_up, *w_down, *ln2_g, *ln2_b;
    float* out;
    bf16_t *H, *PROJN, *VT, *MIX, *Y1, *H1, *ACT, *F, *WIN_T, *WOUT_T, *W1_T, *WD_T, *DUP_T, *IUP_T, *GUP_T;
    char* RWG; int* cnt; int* list_tok; float* list_w; unsigned* bar;
};
typedef const MegaP __attribute__((address_space(4)))* KP;
__device__ __forceinline__ KP kparams_l() { unsigned long long a = (unsigned long long)__builtin_amdgcn_kernarg_segment_ptr(); asm volatile("" : "+s"(a)); return (KP)a; }

__device__ __forceinline__ int perm16(int i) { return (i & 3) | ((i & 4) << 1) | ((i & 8) >> 1); }
__device__ __forceinline__ int vt_pos(int t) { return (t & ~15) | perm16(t & 15); }

__device__ __forceinline__ float lane_read(float v, int src_lane) { return __int_as_float(__builtin_amdgcn_ds_bpermute(src_lane << 2, __float_as_int(v))); }
__device__ __forceinline__ float shx(float v, int m, int lane) { return lane_read(v, lane ^ m); }
__device__ __forceinline__ float wave_sum(float v, int lane) {
#pragma unroll
    for (int o = 32; o > 0; o >>= 1) v += shx(v, o, lane);
    return v;
}
__device__ __forceinline__ float sigmoidf_(float x) { return 1.0f / (1.0f + __expf(-x)); }

struct ConvP { const float *w_in, *w_out, *w_gate, *w_up, *w_down, *decay_up, *iclr_up, *gate_up; bf16_t *WIN_T, *WOUT_T, *W1_T, *WD_T, *DUP_T, *IUP_T, *GUP_T; };
constexpr int CONV_UNITS = 704 + 256 + 2048 + 1024 + 16;
__device__ __forceinline__ int orig_col(int n) { return n < 512 ? n : (n < 2304 ? n + 128 : (n < 2432 ? n - 2304 + 512 : n)); }
__device__ __forceinline__ void conv_unit(const ConvP& P, int u, float* tile  ) {
    const float* src; int ld_src, col0, k0; bf16_t* dst; int ld_dst;
    if (u < 704) { const int nt = u >> 4, kt = u & 15; src = P.w_in; ld_src = INC; col0 = orig_col(nt * 64); k0 = kt * 64; dst = P.WIN_T + (size_t)nt * 64 * 1024; ld_dst = 1024; }
    else if (u < 960) { const int v = u - 704, nt = v >> 4, kt = v & 15; src = P.w_out; ld_src = 1024; col0 = nt * 64; k0 = kt * 64; dst = P.WOUT_T + (size_t)nt * 64 * 1024; ld_dst = 1024; }
    else if (u < 3008) { const int v = u - 960, e = v >> 7, r = v & 127, nt = r >> 4, kt = r & 15, j0 = nt * 64, ct = j0 >> 8, jj = j0 & 255;
        src = (jj < 128 ? P.w_gate : P.w_up) + (size_t)e * 1024 * 256; ld_src = 256; col0 = ct * 128 + (jj & 127); k0 = kt * 64; dst = P.W1_T + (size_t)e * 512 * 1024 + (size_t)j0 * 1024; ld_dst = 1024; }
    else if (u >= 4032) { const int v = u - 4032;
        if (v < 4) { src = P.decay_up; ld_src = 256; col0 = v * 64; k0 = 0; dst = P.DUP_T + (size_t)v * 64 * 64; ld_dst = 64; }
        else if (v < 8) { src = P.iclr_up; ld_src = 256; col0 = (v - 4) * 64; k0 = 0; dst = P.IUP_T + (size_t)(v - 4) * 64 * 64; ld_dst = 64; }
        else { const int w = v - 8; src = P.gate_up; ld_src = 256; col0 = (w >> 1) * 64; k0 = (w & 1) * 64; dst = P.GUP_T + (size_t)(w >> 1) * 64 * 128; ld_dst = 128; } }
    else { const int v = u - 3008, e = v >> 6, r = v & 63, nt = r >> 2, kt = r & 3; src = P.w_down + (size_t)e * 256 * 1024; ld_src = 1024; col0 = nt * 64; k0 = kt * 64; dst = P.WD_T + (size_t)e * 1024 * 256 + (size_t)nt * 64 * 256; ld_dst = 256; }
    const int tid = ltid();
    { const int ty = tid >> 4, tx = tid & 15;
#pragma unroll
      for (int rr = 0; rr < 2; ++rr) { const int k = ty + 32 * rr; const f32x4 v = *(const f32x4*)(src + (size_t)(k0 + k) * ld_src + col0 + 4 * tx);
          tile[k * 65 + 4 * tx + 0] = v[0]; tile[k * 65 + 4 * tx + 1] = v[1]; tile[k * 65 + 4 * tx + 2] = v[2]; tile[k * 65 + 4 * tx + 3] = v[3]; } }
    __syncthreads();
    { const int n = tid >> 3, kc = (tid & 7) * 8; u32x4 w;
      w[0] = pk2(tile[(kc + 0) * 65 + n], tile[(kc + 1) * 65 + n]); w[1] = pk2(tile[(kc + 2) * 65 + n], tile[(kc + 3) * 65 + n]);
      w[2] = pk2(tile[(kc + 4) * 65 + n], tile[(kc + 5) * 65 + n]); w[3] = pk2(tile[(kc + 6) * 65 + n], tile[(kc + 7) * 65 + n]);
      *(u32x4*)(dst + (size_t)n * ld_dst + k0 + kc) = w; }
    __syncthreads();
}

__device__ __forceinline__ void ln_finish_store(const float (&v)[16], const float* __restrict__ g, const float* __restrict__ b, int lane, bf16_t* outb, float* outf) {
    float s = 0.f;
#pragma unroll
    for (int i = 0; i < 16; ++i) s += v[i];
    const float mu = wave_sum(s, lane) * (1.0f / D);
    float q = 0.f;
#pragma unroll
    for (int i = 0; i < 16; ++i) { const float d = v[i] - mu; q += d * d; }
    const float rs = rsqrtf(wave_sum(q, lane) * (1.0f / D) + 1e-5f);
#pragma unroll
    for (int i = 0; i < 4; ++i) { const int col = lane * 4 + 256 * i; const f32x4 gv = *(const f32x4*)(g + col), bv = *(const f32x4*)(b + col);
        float o[4];
#pragma unroll
        for (int j = 0; j < 4; ++j) o[j] = (v[4 * i + j] - mu) * rs * gv[j] + bv[j];
        if (outb) { u32x2 w; w[0] = pk2(o[0], o[1]); w[1] = pk2(o[2], o[3]); *(u32x2*)(outb + col) = w; }
        if (outf) { *(f32x4*)(outf + col) = (f32x4){o[0], o[1], o[2], o[3]}; } }
}

namespace pg8 {
constexpr int BM = 256, BK = 64, HALF = 128, HTB = HALF * BK * 2, STAGE_BYTES = 8 * HTB, NXCD = 8, WGM = 8;
__device__ __forceinline__ int lds_byte(int r, int c) { const int st = (r >> 4) * 2 + (c >> 5), rr = r & 15, cc = c & 31, ob = rr * 64 + cc * 2; return st * 1024 + (ob ^ (((ob >> 9) & 1) << 5)); }
__device__ __forceinline__ void stage_rc(int b, int& R, int& C) { const int st = b / 1024, sb = b % 1024, swz = sb ^ (((sb >> 9) & 1) << 5); R = (st >> 1) * 16 + swz / 64; C = (st & 1) * 32 + (swz % 64) / 2; }
__device__ __forceinline__ int perm32(int rho) { const int n = rho >> 4, i = rho & 15; return 8 * (i >> 2) + 4 * n + (i & 3); }
struct Unit { const char* a; const char* b; int row0, col0, kind, aux, n; };
__device__ __forceinline__ void tile_of(int L, int nM, int nN, int& pm, int& pn) {
    const int nwg = nM * nN; int wgid = L;
    { const int q = nwg / NXCD, r = nwg % NXCD, xcd = wgid % NXCD, off = wgid / NXCD; wgid = (xcd < r ? xcd * (q + 1) : r * (q + 1) + (xcd - r) * q) + off; }
    const int nig = WGM * nN, gid = wgid / nig, fm = gid * WGM, gsz = (nM - fm) < WGM ? (nM - fm) : WGM;
    pm = fm + ((wgid % nig) % gsz); pn = (wgid % nig) / gsz;
}
template <class Epi, class Sched, bool GATHER = false>
__device__ __forceinline__ void gemm_phase(LAS unsigned char* lds, const int K, const Sched& S, const Epi& E) {
    const int tid = ltid(), wid = __builtin_amdgcn_readfirstlane(tid >> 6), lane = tid & 63, wr = wid >> 2, wc = wid & 3, fr = lane & 15, fq = lane >> 4;
    const int nt = K / BK;
    unsigned voffB[2], vAc[2][2], vAn[2][2]; int stR[2], stC[2];
    const size_t kstep = (size_t)(BK * 2);
    const size_t hstep = (size_t)HALF * K * 2;
#pragma unroll
    for (int i = 0; i < 2; ++i) { int R, C; stage_rc(tid * 16 + i * 8192, R, C); const int Rb = Epi::PERM ? ((R & ~31) + perm32(R & 31)) : R; stR[i] = R; stC[i] = C;
        voffB[i] = (unsigned)(Rb * K + C) * 2u;
#pragma unroll
        for (int hf = 0; hf < 2; ++hf) { vAc[hf][i] = (unsigned)(R * K + C) * 2u + (unsigned)(hf * hstep); vAn[hf][i] = vAc[hf][i]; } }
    const unsigned ldsw = (unsigned)wid * 1024u;
    const int aoff = lds_byte(wr * 64 + fr, fq * 8), boff = lds_byte(wc * 32 + fr, fq * 8);
#define PG8_SA(b, h) (((b) * 2 + (h)) * HTB)
#define PG8_SB(b, h) ((4 + (b) * 2 + (h)) * HTB)
#define PG8_STAGE(bufoff, gbase, voff) do { _Pragma("unroll") for (int _i = 0; _i < 2; ++_i) \
        __builtin_amdgcn_global_load_lds((const unsigned*)((const char*)(gbase) + (voff)[_i]), (LAS unsigned*)(lds + (bufoff) + ldsw + _i * 8192), 16, 0, 0); } while (0)
#define PG8_LDA(dst, b, h) do { _Pragma("unroll") for (int m = 0; m < 4; ++m) _Pragma("unroll") for (int k = 0; k < 2; ++k) dst[m][k] = *(const LAS bf16x8*)(lds + PG8_SA(b, h) + aoff + m * 2048 + k * 1024); } while (0)
#define PG8_LDB(dst, b, h) do { _Pragma("unroll") for (int n = 0; n < 2; ++n) _Pragma("unroll") for (int k = 0; k < 2; ++k) dst[n][k] = *(const LAS bf16x8*)(lds + PG8_SB(b, h) + boff + n * 2048 + k * 1024); } while (0)
#define PG8_MMA(ai, bj, At, Bt) do { __builtin_amdgcn_s_setprio(1); _Pragma("unroll") for (int m = 0; m < 4; ++m) _Pragma("unroll") for (int n = 0; n < 2; ++n) _Pragma("unroll") for (int k = 0; k < 2; ++k) \
        acc[ai][bj][m][n] = __builtin_amdgcn_mfma_f32_16x16x32_bf16(Bt[n][k], At[m][k], acc[ai][bj][m][n], 0, 0, 0); __builtin_amdgcn_s_setprio(0); } while (0)
#define PG8_WAIT_V(n) asm volatile("s_waitcnt vmcnt(" #n ")" ::: "memory")
#define PG8_WAIT_L(n) asm volatile("s_waitcnt lgkmcnt(" #n ")" ::: "memory")
#define PG8_BAR __builtin_amdgcn_s_barrier()
#define PG8_SCHED __builtin_amdgcn_sched_barrier(0)
    Unit cur, nxt; int ui = 0;
    if (!S.next(0, cur)) return;
    f32x4 acc[2][2][4][2];
#pragma unroll
    for (int a = 0; a < 2; ++a)
#pragma unroll
        for (int b = 0; b < 2; ++b)
#pragma unroll
            for (int m = 0; m < 4; ++m)
#pragma unroll
                for (int n = 0; n < 2; ++n) acc[a][b][m][n] = (f32x4){0.f, 0.f, 0.f, 0.f};
    bf16x8 At[4][2], B0[2][2], B1[2][2];
    const char* cA = cur.a; const char* cB = cur.b;
    if constexpr (GATHER) {
#pragma unroll
        for (int i = 0; i < 2; ++i)
#pragma unroll
            for (int hf = 0; hf < 2; ++hf) { vAc[hf][i] = S.a_off(cur, hf * HALF + stR[i]) + (unsigned)stC[i] * 2u; vAn[hf][i] = vAc[hf][i]; }
    }
    PG8_STAGE(PG8_SB(0, 0), cB, voffB); PG8_STAGE(PG8_SA(0, 0), cA, vAc[0]); PG8_STAGE(PG8_SB(0, 1), cB + hstep, voffB); PG8_STAGE(PG8_SA(0, 1), cA, vAc[1]);
    if (wr == 1) PG8_BAR;
    PG8_WAIT_V(4); PG8_BAR;
    PG8_STAGE(PG8_SB(1, 0), cB + kstep, voffB); PG8_STAGE(PG8_SA(1, 0), cA + kstep, vAc[0]); PG8_STAGE(PG8_SB(1, 1), cB + hstep + kstep, voffB);
    PG8_WAIT_V(6); PG8_BAR;
    for (;;) {
        const bool has_next = S.next(ui + 1, nxt);
        const char* nA = has_next ? nxt.a : cA; const char* nB = has_next ? nxt.b : cB;
        if constexpr (GATHER) {
            if (has_next) {
#pragma unroll
                for (int i = 0; i < 2; ++i)
#pragma unroll
                    for (int hf = 0; hf < 2; ++hf) vAn[hf][i] = S.a_off(nxt, hf * HALF + stR[i]) + (unsigned)stC[i] * 2u;
            }
        }
        for (int t = 0; t < nt; t += 2) {
            const bool last = (t == nt - 2);
            const char* a1 = cA + (size_t)(t + 1) * kstep;
            const char* a2 = last ? nA : cA + (size_t)(t + 2) * kstep; const char* b2 = last ? nB : cB + (size_t)(t + 2) * kstep;
            const char* a3 = a2 + kstep; const char* b3 = b2 + kstep;
            unsigned vA2[2][2];
#pragma unroll
            for (int i = 0; i < 2; ++i)
#pragma unroll
                for (int hf = 0; hf < 2; ++hf) vA2[hf][i] = (GATHER && last) ? vAn[hf][i] : vAc[hf][i];
            PG8_LDB(B0, 0, 0); PG8_SCHED; PG8_LDA(At, 0, 0); PG8_STAGE(PG8_SA(1, 1), a1, vAc[1]);
            PG8_WAIT_L(8); PG8_BAR; PG8_WAIT_L(0); PG8_MMA(0, 0, At, B0); PG8_BAR; PG8_SCHED;
            PG8_LDB(B1, 0, 1); PG8_STAGE(PG8_SB(0, 0), b2, voffB);
            PG8_BAR; PG8_WAIT_L(0); PG8_MMA(0, 1, At, B1); PG8_BAR;
            PG8_LDA(At, 0, 1); PG8_STAGE(PG8_SA(0, 0), a2, vA2[0]);
            PG8_BAR; PG8_WAIT_L(0); PG8_MMA(1, 0, At, B0); PG8_BAR; PG8_SCHED;
            PG8_STAGE(PG8_SB(0, 1), b2 + hstep, voffB);
            PG8_WAIT_V(6); PG8_BAR; PG8_MMA(1, 1, At, B1); PG8_BAR;
            PG8_LDB(B0, 1, 0); PG8_SCHED; PG8_LDA(At, 1, 0); PG8_STAGE(PG8_SA(0, 1), a2, vA2[1]);
            PG8_WAIT_L(8); PG8_BAR; PG8_WAIT_L(0); PG8_MMA(0, 0, At, B0); PG8_BAR; PG8_SCHED;
            PG8_LDB(B1, 1, 1); PG8_STAGE(PG8_SB(1, 0), b3, voffB);
            PG8_BAR; PG8_WAIT_L(0); PG8_MMA(0, 1, At, B1); PG8_BAR;
            PG8_LDA(At, 1, 1); PG8_STAGE(PG8_SA(1, 0), a3, vA2[0]);
            PG8_BAR; PG8_WAIT_L(0); PG8_MMA(1, 0, At, B0); PG8_BAR; PG8_SCHED;
            PG8_STAGE(PG8_SB(1, 1), b3 + hstep, voffB);
            PG8_WAIT_V(6); PG8_BAR; PG8_MMA(1, 1, At, B1); PG8_BAR;
        }
        { const int tz = ltid(), wz = tz >> 6, lz = tz & 63; E(acc, cur, wz >> 2, wz & 3, lz & 15, lz >> 4); }
        if (!has_next) break;
#pragma unroll
        for (int a = 0; a < 2; ++a)
#pragma unroll
            for (int b = 0; b < 2; ++b)
#pragma unroll
                for (int m = 0; m < 4; ++m)
#pragma unroll
                    for (int n = 0; n < 2; ++n) acc[a][b][m][n] = (f32x4){0.f, 0.f, 0.f, 0.f};
        cur = nxt; cA = nA; cB = nB; ++ui;
#pragma unroll
        for (int i = 0; i < 2; ++i)
#pragma unroll
            for (int hf = 0; hf < 2; ++hf) vAc[hf][i] = vAn[hf][i];
    }
    PG8_WAIT_V(0);
    if (wr == 0) PG8_BAR;
    PG8_BAR;
#undef PG8_SA
#undef PG8_SB
#undef PG8_STAGE
#undef PG8_LDA
#undef PG8_LDB
#undef PG8_MMA
#undef PG8_WAIT_V
#undef PG8_WAIT_L
#undef PG8_BAR
#undef PG8_SCHED
}
}

struct SchedProjN {
    const char* H; const char* W; int G, c;
    __device__ __forceinline__ bool next(int i, pg8::Unit& u) const {
        const int L = i * G + c; if (L >= 576) return false; int pm, pn;
        pg8::tile_of(L, 64, 9, pm, pn); u.a = H + (size_t)pm * 256 * 2048; u.b = W + (size_t)pn * 256 * 2048; u.kind = 0;
        u.row0 = pm * 256; u.col0 = pn * 256; u.aux = 0; u.n = 0; return true;
    }
};
struct SchedProjV {
    const char* H; const char* W; int G, c;
    __device__ __forceinline__ bool next(int i, pg8::Unit& u) const {
        const int L = i * G + c - 64; if (L < 0 || L >= 128 || i > 0) return false; int pm, pn;
        pg8::tile_of(L, 2, 64, pm, pn); u.a = W + (size_t)(2304 + pm * 256) * 2048; u.b = H + (size_t)pn * 256 * 2048; u.kind = 1;
        u.row0 = pm * 256; u.col0 = pn * 256; u.aux = 0; u.n = 0; return true;
    }
};
struct EpiProjN {
    static constexpr bool PERM = true;
    bf16_t* projn;
    __device__ __forceinline__ void operator()(const f32x4 (&acc)[2][2][4][2], const pg8::Unit& u, int wr, int wc, int fr, int fq) const {
        const int row0 = u.row0 + wr * 64 + fr, col0 = u.col0 + wc * 32 + 8 * fq;
#pragma unroll
        for (int ai = 0; ai < 2; ++ai)
#pragma unroll
            for (int m = 0; m < 4; ++m) { bf16_t* rowp = projn + (size_t)(row0 + ai * 128 + m * 16) * PN + col0;
#pragma unroll
                for (int bj = 0; bj < 2; ++bj) { const f32x4 v0 = acc[ai][bj][m][0], v1 = acc[ai][bj][m][1]; u32x4 w;
                    w[0] = pk2(v0[0], v0[1]); w[1] = pk2(v0[2], v0[3]); w[2] = pk2(v1[0], v1[1]); w[3] = pk2(v1[2], v1[3]);
                    *(u32x4*)(rowp + bj * 128) = w; } }
    }
};
struct EpiProjV {
    static constexpr bool PERM = true;
    bf16_t* vt;
    __device__ __forceinline__ void operator()(const f32x4 (&acc)[2][2][4][2], const pg8::Unit& u, int wr, int wc, int fr, int fq) const {
        const int row0 = u.row0 + wr * 64 + fr;
#pragma unroll
        for (int ai = 0; ai < 2; ++ai)
#pragma unroll
            for (int m = 0; m < 4; ++m) { bf16_t* rowp = vt + (size_t)(row0 + ai * 128 + m * 16) * VT_LD + (u.col0 + wc * 32 + 16 * (fq >> 1) + 4 * (fq & 1));
#pragma unroll
                for (int bj = 0; bj < 2; ++bj)
#pragma unroll
                    for (int n = 0; n < 2; ++n) { const f32x4 v = acc[ai][bj][m][n]; u32x2 w; w[0] = pk2(v[0], v[1]); w[1] = pk2(v[2], v[3]);
                        *(u32x2*)(rowp + bj * 128 + 8 * n) = w; } }
    }
};
__device__ __forceinline__ void phase_proj(LAS unsigned char* lds, const bf16_t* H, const bf16_t* WIN_T, bf16_t* projn, bf16_t* vt, int G, int c) {
    { SchedProjN S{(const char*)H, (const char*)WIN_T, G, c}; EpiProjN E{projn}; pg8::gemm_phase<EpiProjN, SchedProjN>(lds, 1024, S, E); }
    { SchedProjV S{(const char*)H, (const char*)WIN_T, G, c}; EpiProjV E{vt}; pg8::gemm_phase<EpiProjV, SchedProjV>(lds, 1024, S, E); }
}
struct SchedWout {
    const char* A; const char* W; int G, c;
    __device__ __forceinline__ bool next(int i, pg8::Unit& u) const {
        const int L = i * G + c; if (L >= 256) return false; int pm, pn; pg8::tile_of(L, 64, 4, pm, pn);
        u.a = A + (size_t)pm * 256 * 2048; u.b = W + (size_t)pn * 256 * 2048; u.row0 = pm * 256; u.col0 = pn * 256; u.kind = 0; u.aux = 0; u.n = 0; return true;
    }
};
struct EpiWout {
    static constexpr bool PERM = true;
    const bf16_t* H; bf16_t* Y1;
    __device__ __forceinline__ void operator()(const f32x4 (&acc)[2][2][4][2], const pg8::Unit& u, int wr, int wc, int fr, int fq) const {
        const int row0 = u.row0 + wr * 64 + fr, col0 = u.col0 + wc * 32 + 8 * fq;
#pragma unroll
        for (int ai = 0; ai < 2; ++ai)
#pragma unroll
            for (int m = 0; m < 4; ++m) { const size_t off = (size_t)(row0 + ai * 128 + m * 16) * D + col0;
#pragma unroll
                for (int bj = 0; bj < 2; ++bj) { const f32x4 v0 = acc[ai][bj][m][0], v1 = acc[ai][bj][m][1]; const u32x4 h = *(const u32x4*)(H + off + bj * 128); u32x4 w;
                    w[0] = pk2(ALPHA * bflo(h[0]) + v0[0], ALPHA * bfhi(h[0]) + v0[1]); w[1] = pk2(ALPHA * bflo(h[1]) + v0[2], ALPHA * bfhi(h[1]) + v0[3]);
                    w[2] = pk2(ALPHA * bflo(h[2]) + v1[0], ALPHA * bfhi(h[2]) + v1[1]); w[3] = pk2(ALPHA * bflo(h[3]) + v1[2], ALPHA * bfhi(h[3]) + v1[3]);
                    *(u32x4*)(Y1 + off + bj * 128) = w; } }
    }
};

#define MFMA32(a, b, c) __builtin_amdgcn_mfma_f32_32x32x16_bf16((a), (b), (c), 0, 0, 0)
template <int S_> __device__ __forceinline__ bf16x8 pack8(const f32x16& x) {
    u32x4 p; p[0] = pk2(x[8 * S_], x[8 * S_ + 1]); p[1] = pk2(x[8 * S_ + 2], x[8 * S_ + 3]); p[2] = pk2(x[8 * S_ + 4], x[8 * S_ + 5]); p[3] = pk2(x[8 * S_ + 6], x[8 * S_ + 7]);
    return __builtin_bit_cast(bf16x8, p);
}
__device__ __forceinline__ f32x16 zero16() { f32x16 z;
#pragma unroll
    for (int i = 0; i < 16; ++i) z[i] = 0.f;
    return z; }
constexpr float LOG2E = 1.4426950408889634f;
__device__ __forceinline__ int t5_bucket(int dist) {
    if (dist < 16) return dist;
    int large = 16 + (int)(logf((float)dist * (1.0f / 16.0f)) / 2.0794415416798357f * 16.0f);
    return large < 31 ? large : 31;
}
__device__ __forceinline__ void attn_c_unit(const bf16_t* __restrict__ projn, const bf16_t* __restrict__ vt, bf16_t* __restrict__ mix, int b, int qt, int h, int lane) {
    const int q = lane & 31, hh = lane >> 5;
    const size_t tq = (size_t)b * SEQ + qt * 32 + q;
    bf16x8 qf[4];
#pragma unroll
    for (int s = 0; s < 4; ++s) qf[s] = *(const bf16x8*)(projn + tq * PN + C_QC + h * 64 + 16 * s + 8 * hh);
    bf16x8 tri[2];
#pragma unroll
    for (int s = 0; s < 2; ++s)
#pragma unroll
        for (int j = 0; j < 8; ++j) { const int kp = 16 * s + 8 * (j >> 2) + 4 * hh + (j & 3); tri[s][j] = (short)(kp > q ? 0x3F80 : 0); }
    f32x16 O0 = zero16(), O1 = zero16(); float carry = 0.f;
    const float c2 = 0.125f * LOG2E;
    for (int kt = qt; kt >= 0; --kt) {
        const size_t tk = (size_t)b * SEQ + kt * 32;
        bf16x8 kf[4];
#pragma unroll
        for (int s = 0; s < 4; ++s) kf[s] = *(const bf16x8*)(projn + (tk + q) * PN + C_KC + h * 64 + 16 * s + 8 * hh);
        bf16x8 vf[2][2];
#pragma unroll
        for (int s = 0; s < 2; ++s)
#pragma unroll
            for (int dt = 0; dt < 2; ++dt) vf[s][dt] = *(const bf16x8*)(vt + (size_t)(128 + h * 64 + dt * 32 + q) * VT_LD + tk + 16 * s + 8 * hh);
        f32x16 Z = zero16();
#pragma unroll
        for (int s = 0; s < 4; ++s) Z = MFMA32(kf[s], qf[s], Z);
        const bool diag = (kt == qt);
        f32x16 lk, lb;
#pragma unroll
        for (int r = 0; r < 16; ++r) {
            const float z = Z[r] * c2;
            const float sp = fmaxf(z, 0.f) + __builtin_amdgcn_logf(1.0f + __builtin_amdgcn_exp2f(-fabsf(z)));
            float l = -sp, bb = z - sp;
            if (diag) { const int krow = (r & 3) + 8 * (r >> 2) + 4 * hh; const bool valid = krow < q; l = valid ? l : 0.f; bb = valid ? bb : -1e30f; }
            lk[r] = l; lb[r] = bb;
        }
        f32x16 Sx;
#pragma unroll
        for (int r = 0; r < 16; ++r) Sx[r] = carry;
        Sx = MFMA32(tri[0], pack8<0>(lk), Sx);
        Sx = MFMA32(tri[1], pack8<1>(lk), Sx);
        f32x16 W; float tot = 0.f;
#pragma unroll
        for (int r = 0; r < 16; ++r) { W[r] = __builtin_amdgcn_exp2f(lb[r] + Sx[r]); tot += lk[r]; }
        tot += shx(tot, 32, lane);
        carry += tot;
        { const bf16x8 wf = pack8<0>(W); O0 = MFMA32(vf[0][0], wf, O0); O1 = MFMA32(vf[0][1], wf, O1); }
        { const bf16x8 wf = pack8<1>(W); O0 = MFMA32(vf[1][0], wf, O0); O1 = MFMA32(vf[1][1], wf, O1); }
        if (__builtin_amdgcn_ballot_w64(carry < -90.0f) == ~0ull) break;
    }
    bf16_t* op = mix + tq * D + 640 + h * 64 + 4 * hh;
#pragma unroll
    for (int g = 0; g < 4; ++g) {
        u32x2 w; w[0] = pk2(O0[4 * g], O0[4 * g + 1]); w[1] = pk2(O0[4 * g + 2], O0[4 * g + 3]); *(u32x2*)(op + 8 * g) = w;
        u32x2 w1; w1[0] = pk2(O1[4 * g], O1[4 * g + 1]); w1[1] = pk2(O1[4 * g + 2], O1[4 * g + 3]); *(u32x2*)(op + 32 + 8 * g) = w1;
    }
}
__device__ __forceinline__ void attn_a_unit(const bf16_t* __restrict__ projn, const bf16_t* __restrict__ vt, const float* __restrict__ sinks, const LAS float* biasL,
                                            bf16_t* __restrict__ mix, int b, int qt, int hq, int lane) {
    const int q = lane & 31, hh = lane >> 5, kv = hq / 3;
    const size_t tq = (size_t)b * SEQ + qt * 32 + q;
    bf16x8 qf[4];
#pragma unroll
    for (int s = 0; s < 4; ++s) qf[s] = *(const bf16x8*)(projn + tq * PN + C_QA + hq * 64 + 16 * s + 8 * hh);
    const float c2 = 0.125f * LOG2E;
    const float sink2 = sinks[hq] * LOG2E;
    f32x16 L[5]; float m2 = sink2;
#pragma unroll
    for (int i = 0; i < 5; ++i) {
        const int kt = qt - 4 + i;
        if (kt >= 0) {
            const size_t tk = (size_t)b * SEQ + kt * 32;
            bf16x8 kf[4];
#pragma unroll
            for (int s = 0; s < 4; ++s) kf[s] = *(const bf16x8*)(projn + (tk + q) * PN + C_KA + kv * 64 + 16 * s + 8 * hh);
            f32x16 Z = zero16();
#pragma unroll
            for (int s = 0; s < 4; ++s) Z = MFMA32(kf[s], qf[s], Z);
#pragma unroll
            for (int r = 0; r < 16; ++r) {
                const int krow = (r & 3) + 8 * (r >> 2) + 4 * hh; const int dist = (4 - i) * 32 + q - krow;
                const bool valid = (i == 0) ? (dist < 128) : ((i == 4) ? (dist >= 0) : true);
                const float l2 = valid ? Z[r] * c2 + biasL[hq * 128 + (dist & 127)] : -INFINITY;
                L[i][r] = l2; m2 = fmaxf(m2, l2);
            }
        } else {
#pragma unroll
            for (int r = 0; r < 16; ++r) L[i][r] = -INFINITY;
        }
    }
    m2 = fmaxf(m2, shx(m2, 32, lane));
    float den = 0.f;
#pragma unroll
    for (int i = 0; i < 5; ++i)
#pragma unroll
        for (int r = 0; r < 16; ++r) { const float p = __builtin_amdgcn_exp2f(L[i][r] - m2); L[i][r] = p; den += p; }
    den += shx(den, 32, lane);
    den += __builtin_amdgcn_exp2f(sink2 - m2);
    f32x16 O0 = zero16(), O1 = zero16();
#pragma unroll
    for (int i = 0; i < 5; ++i) {
        const int kt = qt - 4 + i;
        if (kt >= 0) {
            const size_t tk = (size_t)b * SEQ + kt * 32;
            const bf16_t* vp = vt + (size_t)(kv * 64 + q) * VT_LD + tk + 8 * hh;
            const bf16x8 v00 = *(const bf16x8*)(vp), v01 = *(const bf16x8*)(vp + (size_t)32 * VT_LD), v10 = *(const bf16x8*)(vp + 16), v11 = *(const bf16x8*)(vp + (size_t)32 * VT_LD + 16);
            { const bf16x8 pf = pack8<0>(L[i]); O0 = MFMA32(v00, pf, O0); O1 = MFMA32(v01, pf, O1); }
            { const bf16x8 pf = pack8<1>(L[i]); O0 = MFMA32(v10, pf, O0); O1 = MFMA32(v11, pf, O1); }
        }
    }
    const float inv = 1.0f / den;
    bf16_t* op = mix + tq * D + hq * 64 + 4 * hh;
#pragma unroll
    for (int g = 0; g < 4; ++g) {
        u32x2 w; w[0] = pk2(O0[4 * g] * inv, O0[4 * g + 1] * inv); w[1] = pk2(O0[4 * g + 2] * inv, O0[4 * g + 3] * inv); *(u32x2*)(op + 8 * g) = w;
        u32x2 w1; w1[0] = pk2(O1[4 * g] * inv, O1[4 * g + 1] * inv); w1[1] = pk2(O1[4 * g + 2] * inv, O1[4 * g + 3] * inv); *(u32x2*)(op + 32 + 8 * g) = w1;
    }
}
constexpr int ATT_UNITS = 2 * 256 * 6;
__device__ __forceinline__ void phase_attn(LAS unsigned char* lds, const bf16_t* projn, const bf16_t* vt, const float* sinks, const float* rel_bias, bf16_t* mix, int wave0, int nwaves) {
    LAS float* biasL = (LAS float*)lds;
    for (int i = ltid(); i < 768; i += NTHR) { const int hq = i >> 7, dist = i & 127; biasL[i] = rel_bias[t5_bucket(dist) * 6 + hq] * LOG2E; }
    __syncthreads();
    const int lane = ltid() & 63;
    for (int u = wave0; u < 2 * ATT_UNITS; u += nwaves) {
        const int v = u >= ATT_UNITS ? u - ATT_UNITS : u; const int h = v % 6, qt = (v / 6) & 255, b = v / 1536;
        if (u < ATT_UNITS) attn_c_unit(projn, vt, mix, b, qt, h, lane); else attn_a_unit(projn, vt, sinks, biasL, mix, b, qt, h, lane);
    }
}

#define MFMA16(a, b, c) __builtin_amdgcn_mfma_f32_16x16x32_bf16((a), (b), (c), 0, 0, 0)
constexpr int LDW = 72;
constexpr int RBUF = 64 * LDW * 2;
constexpr int RW_LDS = 14 * RBUF + 4096 + 256;
struct RwkvW { const float *shift_mu, *decay_w0, *iclr_a0, *k_k, *k_a, *r_k, *lnx_g, *lnx_b; const bf16_t *DUP_T, *IUP_T, *GUP_T; };
struct RwkvG { bf16_t* PT; float* QT; bf16_t* GT; bf16_t* YL; bf16_t* S0; bf16_t* G; float* BON; };
constexpr size_t RWG_PT = 0, RWG_QT = RWG_PT + (size_t)1024 * 8192, RWG_GT = RWG_QT + (size_t)1024 * 16384, RWG_YL = RWG_GT + (size_t)1024 * 8192,
                 RWG_S0 = RWG_YL + (size_t)1024 * 8192, RWG_G = RWG_S0 + (size_t)1024 * 8192, RWG_BON = RWG_G + (size_t)NTOK * 256 * 2, RWG_END = RWG_BON + (size_t)NTOK * 4 * 4;

template <class F> __device__ __forceinline__ void mm64(const LAS bf16_t* X, const LAS bf16_t* Y, int wid, int lane, F epi) {
    const int rt = wid >> 1, chh = wid & 1, fr = lane & 15, fq = lane >> 4;
    f32x4 a0 = {0.f, 0.f, 0.f, 0.f}, a1 = {0.f, 0.f, 0.f, 0.f};
#pragma unroll
    for (int ks = 0; ks < 2; ++ks) {
        const bf16x8 a = *(const LAS bf16x8*)(X + (16 * rt + fr) * LDW + 32 * ks + 8 * fq);
        const bf16x8 b0 = *(const LAS bf16x8*)(Y + (32 * chh + fr) * LDW + 32 * ks + 8 * fq);
        const bf16x8 b1 = *(const LAS bf16x8*)(Y + (32 * chh + 16 + fr) * LDW + 32 * ks + 8 * fq);
        a0 = MFMA16(a, b0, a0); a1 = MFMA16(a, b1, a1);
    }
#pragma unroll
    for (int r = 0; r < 4; ++r) { epi(16 * rt + 4 * fq + r, 32 * chh + fr, a0[r]); epi(16 * rt + 4 * fq + r, 32 * chh + 16 + fr, a1[r]); }
}
__device__ __forceinline__ void shifted8(const bf16_t* cur, bool hasprev, const float* mu, float (&x)[8]) {
    const u32x4 cw = *(const u32x4*)cur; u32x4 pw = {0u, 0u, 0u, 0u}; if (hasprev) pw = *(const u32x4*)(cur - PN);
    const f32x4 m0 = *(const f32x4*)mu, m1 = *(const f32x4*)(mu + 4);
#pragma unroll
    for (int i = 0; i < 4; ++i) { const float c0 = bflo(cw[i]), c1 = bfhi(cw[i]), p0 = bflo(pw[i]), p1 = bfhi(pw[i]); const float ma = i < 2 ? m0[2 * i] : m1[2 * i - 4], mb = i < 2 ? m0[2 * i + 1] : m1[2 * i - 3];
        x[2 * i] = c0 + (p0 - c0) * ma; x[2 * i + 1] = c1 + (p1 - c1) * mb; }
}
__device__ __forceinline__ bf16x8 pack8f(const float (&x)[8]) { u32x4 p; p[0] = pk2(x[0], x[1]); p[1] = pk2(x[2], x[3]); p[2] = pk2(x[4], x[5]); p[3] = pk2(x[6], x[7]); return __builtin_bit_cast(bf16x8, p); }
__device__ __forceinline__ float fast_tanh(float x) { const float e = __expf(-2.0f * fabsf(x)); const float t = (1.0f - e) / (1.0f + e); return x < 0.f ? -t : t; }

__device__ __forceinline__ void rwkv_prep_unit(LAS unsigned char* lds, const bf16_t* __restrict__ projn, const RwkvW& W, const RwkvG& Gp, int b, int c, int h) {
    const int tid = ltid(), wid = tid >> 6, lane = tid & 63, fr = lane & 15, fq = lane >> 4;
    const size_t tok0 = (size_t)b * SEQ + (size_t)c * 64; const bool first = (c == 0);
    const int uidx = (b * 128 + c) * 4 + h;
#define RB(i) ((LAS bf16_t*)(lds + (i) * RBUF))
    LAS float* LWs = (LAS float*)(lds + 8 * RBUF); LAS float* AAs = LWs + 64 * 65;
    LAS float* PART = (LAS float*)(lds + 14 * RBUF); LAS float* GCs = PART + 1024;
    {
        const int rt = wid >> 1, chh = wid & 1, t = 16 * rt + fr; const bool hasprev = !(first && t == 0);
        const bf16_t* cur = projn + (tok0 + t) * PN + C_PB;
        f32x4 aU[2], aA[2], aG[2];
#pragma unroll
        for (int n = 0; n < 2; ++n) { aU[n] = (f32x4){0.f, 0.f, 0.f, 0.f}; aA[n] = aU[n]; aG[n] = aU[n]; }
#pragma unroll
        for (int ks = 0; ks < 2; ++ks) {
            float x[8]; const int col = 768 + 32 * ks + 8 * fq; shifted8(cur + col, hasprev, W.shift_mu + col, x);
#pragma unroll
            for (int i = 0; i < 8; ++i) x[i] = fast_tanh(x[i]);
            const bf16x8 a = pack8f(x);
#pragma unroll
            for (int n = 0; n < 2; ++n) { const bf16x8 bb = *(const bf16x8*)(W.DUP_T + (size_t)(h * 64 + 32 * chh + 16 * n + fr) * 64 + 32 * ks + 8 * fq); aU[n] = MFMA16(a, bb, aU[n]); }
        }
#pragma unroll
        for (int ks = 0; ks < 2; ++ks) {
            float x[8]; const int col = 832 + 32 * ks + 8 * fq; shifted8(cur + col, hasprev, W.shift_mu + col, x);
            const bf16x8 a = pack8f(x);
#pragma unroll
            for (int n = 0; n < 2; ++n) { const bf16x8 bb = *(const bf16x8*)(W.IUP_T + (size_t)(h * 64 + 32 * chh + 16 * n + fr) * 64 + 32 * ks + 8 * fq); aA[n] = MFMA16(a, bb, aA[n]); }
        }
#pragma unroll
        for (int ks = 0; ks < 4; ++ks) {
            float x[8]; const int col = 896 + 32 * ks + 8 * fq; shifted8(cur + col, hasprev, W.shift_mu + col, x);
#pragma unroll
            for (int i = 0; i < 8; ++i) x[i] = sigmoidf_(x[i]);
            const bf16x8 a = pack8f(x);
#pragma unroll
            for (int n = 0; n < 2; ++n) { const bf16x8 bb = *(const bf16x8*)(W.GUP_T + (size_t)(h * 64 + 32 * chh + 16 * n + fr) * 128 + 32 * ks + 8 * fq); aG[n] = MFMA16(a, bb, aG[n]); }
        }
#pragma unroll
        for (int n = 0; n < 2; ++n)
#pragma unroll
            for (int r = 0; r < 4; ++r) { const int t_ = 16 * rt + 4 * fq + r, ch = 32 * chh + 16 * n + fr, cidx = h * 64 + ch;
                LWs[t_ * 65 + ch] = -0.6065306597f * sigmoidf_(aU[n][r] + W.decay_w0[cidx]);
                AAs[t_ * 65 + ch] = sigmoidf_(aA[n][r] + W.iclr_a0[cidx]);
                Gp.G[(tok0 + t_) * 256 + cidx] = f2bf(aG[n][r]); }
    }
    __syncthreads();
    {
        const int t = lane, cg = wid, col0 = h * 64 + cg * 8; const bool hasprev = !(first && t == 0);
        const bf16_t* cur = projn + (tok0 + t) * PN + C_PB;
        float r[8], k[8], v[8];
        shifted8(cur + col0, hasprev, W.shift_mu + col0, r); shifted8(cur + 256 + col0, hasprev, W.shift_mu + 256 + col0, k); shifted8(cur + 512 + col0, hasprev, W.shift_mu + 512 + col0, v);
        float lw[8], aa[8], L[8], LC[8], kk[8], km[8]; float ss = 0.f, bn = 0.f;
#pragma unroll
        for (int i = 0; i < 8; ++i) { lw[i] = LWs[t * 65 + cg * 8 + i]; aa[i] = AAs[t * 65 + cg * 8 + i]; }
#pragma unroll
        for (int i = 0; i < 8; ++i) { float x = lw[i];
#pragma unroll
            for (int o = 1; o < 64; o <<= 1) { const float n = lane_read(x, lane >= o ? lane - o : lane); if (lane >= o) x += n; }
            L[i] = x; LC[i] = lane_read(x, 63); }
#pragma unroll
        for (int i = 0; i < 8; ++i) { const int cidx = col0 + i; kk[i] = k[i] * W.k_k[cidx]; ss += kk[i] * kk[i]; km[i] = k[i] * (1.0f + (aa[i] - 1.0f) * W.k_a[cidx]); bn += r[i] * km[i] * W.r_k[cidx]; }
        PART[cg * 64 + t] = ss; PART[512 + cg * 64 + t] = bn;
        __syncthreads();
        float sst = 0.f, bnt = 0.f;
#pragma unroll
        for (int g = 0; g < 8; ++g) { sst += PART[g * 64 + t]; bnt += PART[512 + g * 64 + t]; }
        if (cg == 0) Gp.BON[(tok0 + t) * 4 + h] = bnt;
        const float rn = rsqrtf(fmaxf(sst, 1e-24f));
        float at[8], bt[8], kt[8], rt_[8], bh[8], kh[8];
#pragma unroll
        for (int i = 0; i < 8; ++i) { const float kkn = kk[i] * rn; const float g = __expf(L[i]), gp = __expf(L[i] - lw[i]), gi = __expf(-L[i]), ge = __expf(LC[i] - L[i]);
            at[i] = -kkn * gp; bt[i] = kkn * aa[i] * gi; kt[i] = km[i] * gi; rt_[i] = r[i] * g; bh[i] = kkn * aa[i] * ge; kh[i] = km[i] * ge; }
        *(LAS bf16x8*)(RB(0) + t * LDW + cg * 8) = pack8f(at); *(LAS bf16x8*)(RB(1) + t * LDW + cg * 8) = pack8f(bt);
        *(LAS bf16x8*)(RB(2) + t * LDW + cg * 8) = pack8f(kt); *(LAS bf16x8*)(RB(3) + t * LDW + cg * 8) = pack8f(rt_);
#pragma unroll
        for (int i = 0; i < 8; ++i) { RB(4)[(cg * 8 + i) * LDW + t] = f2bf(at[i]); RB(5)[(cg * 8 + i) * LDW + t] = f2bf(bh[i]); RB(6)[(cg * 8 + i) * LDW + t] = f2bf(v[i]); RB(7)[(cg * 8 + i) * LDW + t] = f2bf(kh[i]); }
        if (t == 63) {
#pragma unroll
            for (int i = 0; i < 8; ++i) GCs[cg * 8 + i] = __expf(LC[i]); }
    }
    __syncthreads();
    mm64(RB(1), RB(0), wid, lane, [&](int j, int t, float v) { const float m = j < t ? v : 0.f; RB(8)[j * LDW + t] = f2bf(m + (j == t ? 1.0f : 0.f)); RB(9)[j * LDW + t] = f2bf(m); RB(10)[t * LDW + j] = f2bf(m); });
    mm64(RB(2), RB(0), wid, lane, [&](int j, int t, float v) { RB(11)[j * LDW + t] = f2bf(j < t ? v : 0.f); });
    mm64(RB(3), RB(1), wid, lane, [&](int t, int i, float v) { RB(12)[t * LDW + i] = f2bf(i <= t ? v : 0.f); });
    mm64(RB(3), RB(2), wid, lane, [&](int t, int j, float v) { RB(13)[t * LDW + j] = f2bf(j <= t ? v : 0.f); });
    __syncthreads();
    auto sq = [&](int sp, int spt, int dp, int dpt) { mm64(RB(sp), RB(spt), wid, lane, [&](int i, int j, float v) { RB(dp)[i * LDW + j] = f2bf(v); RB(dpt)[j * LDW + i] = f2bf(v); }); };
    auto tmu = [&](int st, int spt, int dt) { mm64(RB(st), RB(spt), wid, lane, [&](int i, int j, float v) { RB(dt)[i * LDW + j] = f2bf(v + bf2f(RB(st)[i * LDW + j])); }); };
    sq(9, 10, 0, 1); __syncthreads();
    tmu(8, 1, 2); sq(0, 1, 9, 10); __syncthreads();
    tmu(2, 10, 8); sq(9, 10, 0, 1); __syncthreads();
    tmu(8, 1, 2); sq(0, 1, 9, 10); __syncthreads();
    tmu(2, 10, 8); sq(9, 10, 0, 1); __syncthreads();
    tmu(8, 1, 2); __syncthreads();
    mm64(RB(5), RB(2), wid, lane, [&](int k2, int j, float v) { RB(9)[k2 * LDW + j] = f2bf(v); });
    mm64(RB(12), RB(2), wid, lane, [&](int t, int j, float v) { RB(10)[t * LDW + j] = f2bf(v); });
    __syncthreads();
    { bf16_t* PTu = Gp.PT + (size_t)uidx * 4096;
      mm64(RB(9), RB(4), wid, lane, [&](int k2, int k1, float v) { const float p = v + (k2 == k1 ? GCs[k2] : 0.f);
          const int rtk = k1 >> 4, q = (k1 >> 2) & 3, jj = k1 & 3, s_ = rtk >> 1, j = 4 * (rtk & 1) + jj;
          PTu[(((k2 >> 4) * 2 + s_) * 64 + q * 16 + (k2 & 15)) * 8 + j] = f2bf(p); }); }
    mm64(RB(9), RB(11), wid, lane, [&](int k2, int j, float v) { RB(0)[k2 * LDW + j] = f2bf(v + bf2f(RB(7)[k2 * LDW + j])); });
    { bf16_t* GTu = Gp.GT + (size_t)uidx * 4096;
      mm64(RB(10), RB(4), wid, lane, [&](int t, int k, float v) { GTu[t * 64 + k] = f2bf(v + bf2f(RB(3)[t * LDW + k])); }); }
    mm64(RB(10), RB(11), wid, lane, [&](int t, int j, float v) { RB(1)[t * LDW + j] = f2bf(v + bf2f(RB(13)[t * LDW + j])); });
    __syncthreads();
    { float* QTu = Gp.QT + (size_t)uidx * 4096;
      mm64(RB(0), RB(6), wid, lane, [&](int k2, int vv, float v) { QTu[(((vv >> 4) * 4 + (k2 >> 4)) * 64 + ((k2 >> 2) & 3) * 16 + (vv & 15)) * 4 + (k2 & 3)] = v; }); }
    { bf16_t* YLu = Gp.YL + (size_t)uidx * 4096;
      mm64(RB(1), RB(6), wid, lane, [&](int t, int vv, float v) { YLu[t * 64 + vv] = f2bf(v); }); }
    __syncthreads();
#undef RB
}
__device__ __forceinline__ void rwkv_scan_wave(const RwkvG& Gp, int b, int h, int sl, int lane) {
    bf16x8 sB[2];
#pragma unroll
    for (int s = 0; s < 2; ++s)
#pragma unroll
        for (int j = 0; j < 8; ++j) sB[s][j] = 0;
    const int q = lane >> 4, vv = 16 * sl + (lane & 15);
    bf16x8 pa[4][2]; f32x4 qa[4];
    { const int uidx = (b * 128 + 0) * 4 + h; const bf16_t* PTu = Gp.PT + (size_t)uidx * 4096; const float* QTu = Gp.QT + (size_t)uidx * 4096;
#pragma unroll
      for (int r2 = 0; r2 < 4; ++r2) { pa[r2][0] = *(const bf16x8*)(PTu + ((r2 * 2 + 0) * 64 + lane) * 8); pa[r2][1] = *(const bf16x8*)(PTu + ((r2 * 2 + 1) * 64 + lane) * 8); qa[r2] = *(const f32x4*)(QTu + ((sl * 4 + r2) * 64 + lane) * 4); } }
    for (int c = 0; c < 128; ++c) {
        const int uidx = (b * 128 + c) * 4 + h;
        { bf16_t* S0u = Gp.S0 + (size_t)uidx * 4096 + vv * 64;
#pragma unroll
          for (int s = 0; s < 2; ++s)
#pragma unroll
              for (int jh = 0; jh < 2; ++jh) { u32x2 w; const u32x4 sw = __builtin_bit_cast(u32x4, sB[s]); w[0] = sw[2 * jh]; w[1] = sw[2 * jh + 1]; *(u32x2*)(S0u + 16 * (2 * s + jh) + 4 * q) = w; } }
        bf16x8 pn[4][2]; f32x4 qn[4];
        { const int cn = c < 127 ? c + 1 : c; const int un = (b * 128 + cn) * 4 + h; const bf16_t* PTu = Gp.PT + (size_t)un * 4096; const float* QTu = Gp.QT + (size_t)un * 4096;
#pragma unroll
          for (int r2 = 0; r2 < 4; ++r2) { pn[r2][0] = *(const bf16x8*)(PTu + ((r2 * 2 + 0) * 64 + lane) * 8); pn[r2][1] = *(const bf16x8*)(PTu + ((r2 * 2 + 1) * 64 + lane) * 8); qn[r2] = *(const f32x4*)(QTu + ((sl * 4 + r2) * 64 + lane) * 4); } }
        f32x4 acc[4];
#pragma unroll
        for (int r2 = 0; r2 < 4; ++r2) { acc[r2] = MFMA16(pa[r2][0], sB[0], qa[r2]); acc[r2] = MFMA16(pa[r2][1], sB[1], acc[r2]); }
#pragma unroll
        for (int s = 0; s < 2; ++s) { u32x4 p; p[0] = pk2(acc[2 * s][0], acc[2 * s][1]); p[1] = pk2(acc[2 * s][2], acc[2 * s][3]); p[2] = pk2(acc[2 * s + 1][0], acc[2 * s + 1][1]); p[3] = pk2(acc[2 * s + 1][2], acc[2 * s + 1][3]); sB[s] = __builtin_bit_cast(bf16x8, p); }
#pragma unroll
        for (int r2 = 0; r2 < 4; ++r2) { pa[r2][0] = pn[r2][0]; pa[r2][1] = pn[r2][1]; qa[r2] = qn[r2]; }
    }
}
__device__ __forceinline__ void rwkv_fix_unit(LAS unsigned char* lds, const bf16_t* __restrict__ projn, const RwkvW& W, const RwkvG& Gp, bf16_t* __restrict__ mix, int b, int c, int h) {
    const int tid = ltid(), wid = tid >> 6, lane = tid & 63;
    const size_t tok0 = (size_t)b * SEQ + (size_t)c * 64; const int uidx = (b * 128 + c) * 4 + h;
    LAS bf16_t* Xg = (LAS bf16_t*)lds; LAS bf16_t* Ys = (LAS bf16_t*)(lds + RBUF); LAS float* YF = (LAS float*)(lds + 2 * RBUF);
    { const int row = tid >> 3, cc = (tid & 7) * 8;
      *(LAS u32x4*)(Xg + row * LDW + cc) = *(const u32x4*)(Gp.GT + (size_t)uidx * 4096 + row * 64 + cc);
      *(LAS u32x4*)(Ys + row * LDW + cc) = *(const u32x4*)(Gp.S0 + (size_t)uidx * 4096 + row * 64 + cc); }
    __syncthreads();
    { const bf16_t* YLu = Gp.YL + (size_t)uidx * 4096;
      mm64(Xg, Ys, wid, lane, [&](int t, int vv, float v) { YF[t * 65 + vv] = v + bf2f(YLu[t * 64 + vv]); }); }
    __syncthreads();
    { const int t = tid >> 3, vg = tid & 7, col0 = h * 64 + vg * 8; const bool hasprev = !(c == 0 && t == 0);
      float y[8]; float s = 0.f;
#pragma unroll
      for (int i = 0; i < 8; ++i) { y[i] = YF[t * 65 + vg * 8 + i]; s += y[i]; }
      s += shx(s, 1, lane); s += shx(s, 2, lane); s += shx(s, 4, lane);
      const float mu = s * (1.0f / 64.0f); float qv = 0.f;
#pragma unroll
      for (int i = 0; i < 8; ++i) { const float d = y[i] - mu; qv += d * d; }
      qv += shx(qv, 1, lane); qv += shx(qv, 2, lane); qv += shx(qv, 4, lane);
      const float rs = rsqrtf(qv * (1.0f / 64.0f) + 64e-5f);
      float v[8]; shifted8(projn + (tok0 + t) * PN + C_PB + 512 + col0, hasprev, W.shift_mu + 512 + col0, v);
      const u32x4 gw = *(const u32x4*)(Gp.G + (tok0 + t) * 256 + col0); const float bon = Gp.BON[(tok0 + t) * 4 + h];
      float o[8];
#pragma unroll
      for (int i = 0; i < 8; ++i) { const float g = (i & 1) ? bfhi(gw[i >> 1]) : bflo(gw[i >> 1]); o[i] = ((y[i] - mu) * rs * W.lnx_g[col0 + i] + W.lnx_b[col0 + i] + bon * v[i]) * g; }
      *(bf16x8*)(mix + (tok0 + t) * D + 384 + col0) = pack8f(o); }
    __syncthreads();
}

constexpr int LIST_CAP = 16384;
struct MoeBuf { int* cnt; int* list_tok; float* list_w; };
__device__ __forceinline__ float max3f(float a, float b, float c) { return fmaxf(a, fmaxf(b, c)); }
__device__ __forceinline__ void ln1_route_unit(LAS unsigned char* lds, const bf16_t* __restrict__ Y1, const float* __restrict__ g, const float* __restrict__ bta, bf16_t* __restrict__ H1,
                                               const float* __restrict__ router_w, const float* __restrict__ router_bias, const MoeBuf& mb, int unit, bool load_rw) {
    LAS float* rwT = (LAS float*)lds;
    LAS int* tokE = (LAS int*)(lds + 65536);
    LAS float* tokW = (LAS float*)(lds + 65536 + 512);
    LAS int* ebase = (LAS int*)(lds + 65536 + 1024);
    const int tid = ltid(), wid = tid >> 6, lane = tid & 63;
    if (load_rw) { for (int i = tid; i < 16384; i += NTHR) rwT[(i & 15) * 1024 + (i >> 4)] = router_w[i]; }
    __syncthreads();
    for (int tt = 0; tt < 8; ++tt) {
        const int tl = wid * 8 + tt; const size_t t = (size_t)unit * 64 + tl;
        float v[16];
#pragma unroll
        for (int i = 0; i < 4; ++i) { const u32x2 a = *(const u32x2*)(Y1 + t * D + lane * 4 + 256 * i); v[4 * i] = bflo(a[0]); v[4 * i + 1] = bfhi(a[0]); v[4 * i + 2] = bflo(a[1]); v[4 * i + 3] = bfhi(a[1]); }
        float s = 0.f;
#pragma unroll
        for (int i = 0; i < 16; ++i) s += v[i];
        const float mu = wave_sum(s, lane) * (1.0f / D); float q = 0.f;
#pragma unroll
        for (int i = 0; i < 16; ++i) { const float d = v[i] - mu; q += d * d; }
        const float rs = rsqrtf(wave_sum(q, lane) * (1.0f / D) + 1e-5f);
#pragma unroll
        for (int i = 0; i < 4; ++i) { const int col = lane * 4 + 256 * i; const f32x4 gv = *(const f32x4*)(g + col), bv = *(const f32x4*)(bta + col);
#pragma unroll
            for (int j = 0; j < 4; ++j) v[4 * i + j] = (v[4 * i + j] - mu) * rs * gv[j] + bv[j];
            u32x2 w; w[0] = pk2(v[4 * i], v[4 * i + 1]); w[1] = pk2(v[4 * i + 2], v[4 * i + 3]); *(u32x2*)(H1 + t * D + col) = w; }
        float sc[16], sl[16];
#pragma unroll
        for (int e = 0; e < 16; ++e) { float a = 0.f;
#pragma unroll
            for (int i = 0; i < 4; ++i) { const f32x4 r = *(const LAS f32x4*)(rwT + e * 1024 + lane * 4 + 256 * i); a += v[4 * i] * r[0] + v[4 * i + 1] * r[1] + v[4 * i + 2] * r[2] + v[4 * i + 3] * r[3]; }
            a = wave_sum(a, lane); sc[e] = sigmoidf_(a); sl[e] = sc[e] + router_bias[e]; }
        float gs[4];
#pragma unroll
        for (int gI = 0; gI < 4; ++gI) { const float a = sl[4 * gI], b = sl[4 * gI + 1], c = sl[4 * gI + 2], d = sl[4 * gI + 3]; gs[gI] = fmaxf(max3f(a + b, a + c, a + d), max3f(b + c, b + d, c + d)); }
        int bg = 0; float best = gs[0];
#pragma unroll
        for (int gI = 1; gI < 4; ++gI) if (gs[gI] > best) { best = gs[gI]; bg = gI; }
        float xs[4], xc[4];
#pragma unroll
        for (int i = 0; i < 4; ++i) { xs[i] = bg == 0 ? sl[i] : (bg == 1 ? sl[4 + i] : (bg == 2 ? sl[8 + i] : sl[12 + i])); xc[i] = bg == 0 ? sc[i] : (bg == 1 ? sc[4 + i] : (bg == 2 ? sc[8 + i] : sc[12 + i])); }
        int i1 = 0; float m1 = xs[0];
#pragma unroll
        for (int i = 1; i < 4; ++i) if (xs[i] > m1) { m1 = xs[i]; i1 = i; }
        int i2 = -1; float m2 = -INFINITY;
#pragma unroll
        for (int i = 0; i < 4; ++i) if (i != i1 && xs[i] > m2) { m2 = xs[i]; i2 = i; }
        const float w1 = i1 == 0 ? xc[0] : (i1 == 1 ? xc[1] : (i1 == 2 ? xc[2] : xc[3])), w2 = i2 == 0 ? xc[0] : (i2 == 1 ? xc[1] : (i2 == 2 ? xc[2] : xc[3]));
        const float inv = 1.0f / (w1 + w2);
        if (lane == 0) { tokE[tl * 2] = bg * 4 + i1; tokE[tl * 2 + 1] = bg * 4 + i2; tokW[tl * 2] = w1 * inv; tokW[tl * 2 + 1] = w2 * inv; }
    }
    __syncthreads();
    if (tid < 16) { int n = 0; for (int i = 0; i < 128; ++i) n += (tokE[i] == tid) ? 1 : 0; ebase[tid] = n ? atomicAdd(mb.cnt + tid, n) : 0; }
    __syncthreads();
    if (tid < 128) { const int e = tokE[tid]; int rank = 0; for (int i = 0; i < tid; ++i) rank += (tokE[i] == e) ? 1 : 0; const int p = ebase[e] + rank;
        mb.list_tok[e * LIST_CAP + p] = (unit * 64 + (tid >> 1)) * 2 + (tid & 1); mb.list_w[e * LIST_CAP + p] = tokW[tid]; }
    __syncthreads();
}
constexpr int TILE_TAB_OFF = 131072, TILE_TAB_N = 160;
__device__ __forceinline__ void build_tile_table(LAS unsigned char* lds, const int* cnt, int tid) {
    LAS int* tab = (LAS int*)(lds + TILE_TAB_OFF);
    if (tid < TILE_TAB_N) { int rem = tid, sel = -1;
#pragma unroll
        for (int e = 0; e < 16; ++e) { const int n = __hip_atomic_load(cnt + e, __ATOMIC_RELAXED, __HIP_MEMORY_SCOPE_AGENT); const int te = (n + 255) >> 8; if (sel < 0) { if (rem < te) sel = e | (rem << 4) | (n << 12); else rem -= te; } }
        tab[tid] = sel; }
    __syncthreads();
}
__device__ __forceinline__ int tile_entry(const LAS int* tab, int ti) { return ti < TILE_TAB_N ? __builtin_amdgcn_readfirstlane(tab[ti]) : -1; }
struct SchedMoe1 {
    const char* H1; const char* W1; const int* list_tok; const LAS int* tab; int G, c;
    __device__ __forceinline__ bool next(int i, pg8::Unit& u) const {
        const int L = i * G + c, ti = L >> 1, ct = L & 1; const int v = tile_entry(tab, ti); if (v < 0) return false; const int e = v & 15;
        u.a = H1; u.b = W1 + ((size_t)e * 512 + ct * 256) * 2048; u.row0 = ti * 256; u.col0 = ct * 128; u.kind = e; u.aux = ((v >> 4) & 255) * 256; u.n = v >> 12; return true;
    }
    __device__ __forceinline__ unsigned a_off(const pg8::Unit& u, int r) const { const int p = u.aux + r; const int ent = p < u.n ? list_tok[u.kind * LIST_CAP + p] : 0; return (unsigned)(ent >> 1) * 2048u; }
};
struct EpiMoe1 {
    static constexpr bool PERM = true;
    const float* list_w; bf16_t* ACT;
    __device__ __forceinline__ void operator()(const f32x4 (&acc)[2][2][4][2], const pg8::Unit& u, int wr, int wc, int fr, int fq) const {
#pragma unroll
        for (int ai = 0; ai < 2; ++ai)
#pragma unroll
            for (int m = 0; m < 4; ++m) { const int r = ai * 128 + wr * 64 + m * 16 + fr, p = u.aux + r; const float w = p < u.n ? list_w[u.kind * LIST_CAP + p] : 0.f;
                float o[8];
#pragma unroll
                for (int n = 0; n < 2; ++n)
#pragma unroll
                    for (int j = 0; j < 4; ++j) { const float gq = acc[ai][0][m][n][j], uq = acc[ai][1][m][n][j]; o[4 * n + j] = gq / (1.0f + __expf(-gq)) * uq * w; }
                *(bf16x8*)(ACT + (size_t)(u.row0 + r) * 256 + u.col0 + wc * 32 + 8 * fq) = pack8f(o); }
    }
};
struct SchedMoe2 {
    const char* ACT; const char* WD; const LAS int* tab; int G, c;
    __device__ __forceinline__ bool next(int i, pg8::Unit& u) const {
        const int L = i * G + c, ti = L >> 2, ct = L & 3; const int v = tile_entry(tab, ti); if (v < 0) return false; const int e = v & 15;
        u.a = ACT + (size_t)ti * 256 * 512; u.b = WD + ((size_t)e * 1024 + ct * 256) * 512; u.row0 = ((v >> 4) & 255) * 256; u.col0 = ct * 256; u.kind = e; u.aux = 0; u.n = v >> 12; return true;
    }
};
struct EpiMoe2 {
    static constexpr bool PERM = true;
    __device__ __forceinline__ void operator()(const f32x4 (&acc)[2][2][4][2], const pg8::Unit& u, int wr, int wc, int fr, int fq) const {
        const KP kp = kparams_l(); char* F = (char*)kp->F; const int* lt = kp->list_tok + u.kind * LIST_CAP;
        const unsigned colb = (unsigned)(u.col0 + wc * 32 + 8 * fq) * 2u; const int pbase = u.row0 + wr * 64 + fr;
#pragma unroll
        for (int ai = 0; ai < 2; ++ai)
#pragma unroll
            for (int m = 0; m < 4; ++m) { const int p = pbase + ai * 128 + m * 16;
                if (p < u.n) { const int ent = lt[p]; char* rowp = F + ((unsigned)((ent & 1) * NTOK + (ent >> 1)) * 2048u + colb);
#pragma unroll
                    for (int bj = 0; bj < 2; ++bj) { const f32x4 v0 = acc[ai][bj][m][0], v1 = acc[ai][bj][m][1]; u32x4 w;
                        w[0] = pk2(v0[0], v0[1]); w[1] = pk2(v0[2], v0[3]); w[2] = pk2(v1[0], v1[1]); w[3] = pk2(v1[2], v1[3]); *(u32x4*)(rowp + bj * 256) = w; } }
                asm volatile("" ::: "memory"); }
    }
};


#define XB_TMO      128
#define XB_XCNT(j)  (256  + 64 * (j))
#define XB_XSUB(j)  (1280 + 64 * (j))
#define XB_XGEN(j)  (2304 + 64 * (j))
#define XB_TOP      3328
#define XB_TOPGEN   3392
#define XCD_BAR_WORDS 3456
#define XB_SPIN_CAP (1u << 18)

__device__ __forceinline__ unsigned xb_ld(unsigned* p)              { return __hip_atomic_load(p, __ATOMIC_RELAXED, __HIP_MEMORY_SCOPE_AGENT); }
__device__ __forceinline__ unsigned xb_add(unsigned* p, unsigned v) { return __hip_atomic_fetch_add(p, v, __ATOMIC_RELAXED, __HIP_MEMORY_SCOPE_AGENT); }
__device__ __forceinline__ unsigned xb_xcc_id() { return (unsigned)__builtin_amdgcn_s_getreg((3 << 11) | 20) & 0xFu; }
#define XB_SPIN(cond, bar) do { unsigned _sp = 0; while (cond) { __builtin_amdgcn_s_sleep(1); \
    if ((++_sp & 255u) == 0u) { if (xb_ld(&(bar)[XB_TMO])) break; if (_sp > XB_SPIN_CAP) { atomicAdd(&(bar)[XB_TMO], 1u); break; } } } } while (0)

struct XcdBarrier {
    unsigned* bar; unsigned x;
    volatile LAS unsigned* st;
};

__device__ __forceinline__ XcdBarrier xcd_barrier_post(unsigned* bar, volatile LAS unsigned* st) {
    XcdBarrier b; b.bar = bar; b.x = xb_xcc_id(); b.st = st;
    if (ltid() == 0) (void)xb_add(&bar[XB_XCNT(b.x)], 1u);
    return b;
}
__device__ __forceinline__ void xcd_barrier_complete(unsigned* bar, unsigned x, unsigned& nloc, unsigned& nx) {
    const unsigned G = gridDim.x * gridDim.y * gridDim.z;
    unsigned sum, cnt, mine, sp = 0u;
    for (;;) {
        sum = 0u; cnt = 0u; mine = 0u;
#pragma unroll
        for (unsigned j = 0; j < 16; ++j) { const unsigned c = xb_ld(&bar[XB_XCNT(j)]); sum += c; cnt += (c > 0u) ? 1u : 0u; mine = (j == x) ? c : mine; }
        if (sum == G) break;
        __builtin_amdgcn_s_sleep(1);
        if ((++sp & 255u) == 0u) { if (xb_ld(&bar[XB_TMO])) break; if (sp > XB_SPIN_CAP) { atomicAdd(&bar[XB_TMO], 1u); break; } }
    }
    nloc = mine > 0u ? mine : 1u; nx = cnt > 0u ? cnt : 1u;
}

__device__ __forceinline__ void xcd_barrier(const XcdBarrier& b) {
    asm volatile("s_waitcnt vmcnt(0)" ::: "memory");
    __syncthreads();
    if (ltid() == 0) {
        unsigned* bar = b.bar;
        __builtin_amdgcn_s_waitcnt(0);
        unsigned nloc = b.st[0], nx = b.st[1];
        if (nloc == 0u) { xcd_barrier_complete(bar, b.x, nloc, nx); b.st[0] = nloc; b.st[1] = nx; }
        const unsigned old = xb_add(&bar[XB_XSUB(b.x)], 1u);
        const unsigned gen = old / nloc;
        if (old + 1u == (gen + 1u) * nloc) {
            __builtin_amdgcn_fence(__ATOMIC_RELEASE, "agent");
            asm volatile("s_waitcnt vmcnt(0)" ::: "memory");
            const unsigned og = xb_add(&bar[XB_TOP], 1u);
            const unsigned tg = og / nx;
            if (og + 1u == (tg + 1u) * nx) xb_add(&bar[XB_TOPGEN], 1u);
            else XB_SPIN(xb_ld(&bar[XB_TOPGEN]) == tg, bar);
            __builtin_amdgcn_fence(__ATOMIC_ACQUIRE, "agent");
            xb_add(&bar[XB_XGEN(b.x)], 1u);
            asm volatile("s_waitcnt vmcnt(0)" ::: "memory");
        } else {
            XB_SPIN(xb_ld(&bar[XB_XGEN(b.x)]) == gen, bar);
            __builtin_amdgcn_fence(__ATOMIC_ACQUIRE, "agent");
            asm volatile("s_waitcnt vmcnt(0)" ::: "memory");
        }
    }
    __syncthreads();
}


constexpr int LDS_BAR_OFF = 133632;
constexpr int LDS_TOTAL = LDS_BAR_OFF + 16;
static_assert(RW_LDS <= LDS_BAR_OFF && pg8::STAGE_BYTES <= LDS_BAR_OFF, "LDS map");
constexpr int CONV_A = 976, CONV_B = 3072;
__device__ __forceinline__ int conv_a_unit(int i) { return i < 960 ? i : i - 960 + 4032; }
__device__ __forceinline__ int conv_b_unit(int i) { return i + 960; }

#define PHASE_FN __device__ __forceinline__ void
#define PHASE_PROLOGUE extern __shared__ __attribute__((aligned(16))) unsigned char shm[]; LAS unsigned char* lds = (LAS unsigned char*)shm; const KP p = kparams_l(); \
    const int tid = ltid(); const int c = lbid(); const int G = (int)gridDim.x, wid = tid >> 6, lane = tid & 63; (void)lds; (void)c; (void)G; (void)wid; (void)lane;
__device__ __forceinline__ ConvP conv_params(KP p, int l) {
    ConvP c; c.w_in = p->w_in + (size_t)l * D * INC; c.w_out = p->w_out + (size_t)l * D * D; c.w_gate = p->w_gate + (size_t)l * 16 * 1024 * 256; c.w_up = p->w_up + (size_t)l * 16 * 1024 * 256;
    c.w_down = p->w_down + (size_t)l * 16 * 256 * 1024; c.decay_up = p->decay_up + (size_t)l * 64 * 256; c.iclr_up = p->iclr_up + (size_t)l * 64 * 256; c.gate_up = p->gate_up + (size_t)l * 128 * 256;
    c.WIN_T = p->WIN_T; c.WOUT_T = p->WOUT_T; c.W1_T = p->W1_T; c.WD_T = p->WD_T; c.DUP_T = p->DUP_T; c.IUP_T = p->IUP_T; c.GUP_T = p->GUP_T; return c;
}
__device__ __forceinline__ RwkvW rwkv_w(KP p, int l) { return RwkvW{p->shift_mu + l * 1024, p->decay_w0 + l * 256, p->iclr_a0 + l * 256, p->k_k + l * 256, p->k_a + l * 256, p->r_k + l * 256, p->lnx_g + l * 256, p->lnx_b + l * 256, p->DUP_T, p->IUP_T, p->GUP_T}; }
__device__ __forceinline__ RwkvG rwkv_g(KP p) { char* r = p->RWG; return RwkvG{(bf16_t*)(r + RWG_PT), (float*)(r + RWG_QT), (bf16_t*)(r + RWG_GT), (bf16_t*)(r + RWG_YL), (bf16_t*)(r + RWG_S0), (bf16_t*)(r + RWG_G), (float*)(r + RWG_BON)}; }

PHASE_FN ph_barrier() {
    extern __shared__ __attribute__((aligned(16))) unsigned char shm[];
    XcdBarrier b; b.bar = kparams_l()->bar; b.x = xb_xcc_id(); b.st = (volatile LAS unsigned*)((LAS unsigned char*)shm + LDS_BAR_OFF);
    xcd_barrier(b);
}
PHASE_FN ph_ln0_conv() {
    PHASE_PROLOGUE
    for (int t = c * 8 + wid; t < NTOK; t += G * 8) {
        float v[16];
#pragma unroll
        for (int i = 0; i < 4; ++i) { const f32x4 a = *(const f32x4*)(p->x + (size_t)t * D + lane * 4 + 256 * i); v[4 * i] = a[0]; v[4 * i + 1] = a[1]; v[4 * i + 2] = a[2]; v[4 * i + 3] = a[3]; }
        ln_finish_store(v, p->ln0_g, p->ln0_b, lane, p->H + (size_t)t * D, nullptr);
    }
    const ConvP cp = conv_params(p, 0); for (int i = c; i < CONV_A; i += G) conv_unit(cp, conv_a_unit(i), (float*)shm);
}
PHASE_FN ph_proj() { PHASE_PROLOGUE phase_proj(lds, p->H, p->WIN_T, p->PROJN, p->VT, G, c); }
PHASE_FN ph_rwkv_prep(int l) { PHASE_PROLOGUE const RwkvW Wr = rwkv_w(p, l); const RwkvG Gp = rwkv_g(p); for (int u = c; u < 1024; u += G) rwkv_prep_unit(lds, p->PROJN, Wr, Gp, u >> 9, (u >> 2) & 127, u & 3); }
PHASE_FN ph_scan() { PHASE_PROLOGUE const RwkvG Gp = rwkv_g(p); if (wid < 4) rwkv_scan_wave(Gp, c >> 2, c & 3, wid, lane); }
PHASE_FN ph_conv_attn(int l) {
    PHASE_PROLOGUE
    if (c == 8 && tid < 16) __hip_atomic_store(p->cnt + tid, 0, __ATOMIC_RELAXED, __HIP_MEMORY_SCOPE_AGENT);
    { const ConvP cp = conv_params(p, l); for (int i = c - 8; i < CONV_B; i += G - 8) conv_unit(cp, conv_b_unit(i), (float*)shm); }
    phase_attn(lds, p->PROJN, p->VT, p->sinks + l * 6, p->rel_bias, p->MIX, (c - 8) * 8 + wid, (G - 8) * 8);
}
PHASE_FN ph_rwkv_fix(int l) { PHASE_PROLOGUE const RwkvW Wr = rwkv_w(p, l); const RwkvG Gp = rwkv_g(p); for (int u = c; u < 1024; u += G) rwkv_fix_unit(lds, p->PROJN, Wr, Gp, p->MIX, u >> 9, (u >> 2) & 127, u & 3); }
PHASE_FN ph_wout() { PHASE_PROLOGUE SchedWout S{(const char*)p->MIX, (const char*)p->WOUT_T, G, c}; EpiWout E{p->H, p->Y1}; pg8::gemm_phase<EpiWout, SchedWout>(lds, 1024, S, E); }
PHASE_FN ph_ln1_route(int l) {
    PHASE_PROLOGUE
    MoeBuf mb{p->cnt, p->list_tok, p->list_w}; bool first = true;
    for (int u = c; u < 256; u += G) { ln1_route_unit(lds, p->Y1, p->ln1_g + l * D, p->ln1_b + l * D, p->H1, p->router_w, p->router_bias, mb, u, first); first = false; }
}
PHASE_FN ph_moe1() {
    PHASE_PROLOGUE
    build_tile_table(lds, p->cnt, tid);
    SchedMoe1 S{(const char*)p->H1, (const char*)p->W1_T, p->list_tok, (const LAS int*)(lds + TILE_TAB_OFF), G, c};
    EpiMoe1 E{p->list_w, p->ACT}; pg8::gemm_phase<EpiMoe1, SchedMoe1, true>(lds, 1024, S, E);
}
PHASE_FN ph_moe2() {
    PHASE_PROLOGUE
    build_tile_table(lds, p->cnt, tid);
    SchedMoe2 S{(const char*)p->ACT, (const char*)p->WD_T, (const LAS int*)(lds + TILE_TAB_OFF), G, c};
    int K2 = 256; asm volatile("" : "+s"(K2));
    EpiMoe2 E; pg8::gemm_phase<EpiMoe2, SchedMoe2, false>(lds, K2, S, E);
}
PHASE_FN ph_ln2(int l) {
    PHASE_PROLOGUE
    for (int t = c * 8 + wid; t < NTOK; t += G * 8) {
        float v[16];
#pragma unroll
        for (int i = 0; i < 4; ++i) { const size_t o = (size_t)t * D + lane * 4 + 256 * i; const u32x2 a = *(const u32x2*)(p->H1 + o), f0 = *(const u32x2*)(p->F + o), f1 = *(const u32x2*)(p->F + (size_t)NTOK * D + o);
            v[4 * i] = ALPHA * bflo(a[0]) + bflo(f0[0]) + bflo(f1[0]); v[4 * i + 1] = ALPHA * bfhi(a[0]) + bfhi(f0[0]) + bfhi(f1[0]);
            v[4 * i + 2] = ALPHA * bflo(a[1]) + bflo(f0[1]) + bflo(f1[1]); v[4 * i + 3] = ALPHA * bfhi(a[1]) + bfhi(f0[1]) + bfhi(f1[1]); }
        ln_finish_store(v, p->ln2_g + l * D, p->ln2_b + l * D, lane, l == 0 ? p->H + (size_t)t * D : nullptr, l == 1 ? p->out + (size_t)t * D : nullptr);
    }
    if (l == 0) { const ConvP cp = conv_params(p, 1); for (int i = c; i < CONV_A; i += G) conv_unit(cp, conv_a_unit(i), (float*)shm); }
}

__global__ void __launch_bounds__(NTHR, 2) k_mega(MegaP pp) {
    (void)pp;
    extern __shared__ __attribute__((aligned(16))) unsigned char shm[];
    { LAS unsigned* st = (LAS unsigned*)((LAS unsigned char*)shm + LDS_BAR_OFF);
      if (ltid() == 0) { st[0] = 0u; st[1] = 0u; st[2] = 0u; st[3] = 0u; }
      __syncthreads();
      (void)xcd_barrier_post(kparams_l()->bar, (volatile LAS unsigned*)st); }
    ph_ln0_conv();
    ph_barrier();
    for (int l = 0; l < 2; ++l) {
        ph_proj(); ph_barrier();
        ph_rwkv_prep(l); ph_barrier();
        { int cb = lbid(); asm volatile("" : "+s"(cb)); if (cb < 8) ph_scan(); else ph_conv_attn(l); }
        ph_barrier();
        ph_rwkv_fix(l); ph_barrier();
        ph_wout(); ph_barrier();
        ph_ln1_route(l); ph_barrier();
        ph_moe1(); ph_barrier();
        ph_moe2(); ph_barrier();
        ph_ln2(l);
        if (l == 0) ph_barrier();
    }
}

extern "C" void kernel_launch(void* const* d_in, const int* in_sizes, int n_in, void* d_out, int out_size, void* d_ws, size_t ws_size, hipStream_t stream) {
    const size_t MiB = 1048576;
    char* ws = (char*)d_ws;
    MegaP p{};
    const float** pin = (const float**)&p;
    for (int i = 0; i < 27; ++i) pin[i] = (const float*)d_in[i];
    p.out = (float*)d_out;
    p.H = (bf16_t*)(ws); p.PROJN = (bf16_t*)(ws + 32 * MiB); p.VT = (bf16_t*)(ws + 104 * MiB); p.MIX = (bf16_t*)(ws + 120 * MiB);
    p.Y1 = (bf16_t*)(ws + 32 * MiB); p.H1 = (bf16_t*)(ws + 64 * MiB); p.ACT = (bf16_t*)(ws + 96 * MiB); p.F = (bf16_t*)(ws + 120 * MiB);
    p.RWG = ws + 152 * MiB;
    bf16_t* Wb = (bf16_t*)(ws + 220 * MiB);
    p.WIN_T = Wb; p.WOUT_T = Wb + (size_t)2816 * 1024; p.W1_T = p.WOUT_T + (size_t)1024 * 1024; p.WD_T = p.W1_T + (size_t)16 * 512 * 1024;
    p.DUP_T = p.WD_T + (size_t)16 * 1024 * 256; p.IUP_T = p.DUP_T + 256 * 64; p.GUP_T = p.IUP_T + 256 * 64;
    char* MISC = ws + 252 * MiB;
    p.cnt = (int*)MISC; p.list_tok = (int*)(MISC + 4096); p.list_w = (float*)(MISC + 4096 + (size_t)16 * LIST_CAP * 4);
    p.bar = (unsigned*)(MISC + 4096 + (size_t)32 * LIST_CAP * 4);
    static int grid = 0;
    if (grid == 0) {
        int dev = 0, cus = 0;
        if (hipGetDevice(&dev) != hipSuccess || hipDeviceGetAttribute(&cus, hipDeviceAttributeMultiprocessorCount, dev) != hipSuccess) { grid = -1; return; }
        if (hipFuncSetAttribute((const void*)k_mega, hipFuncAttributeMaxDynamicSharedMemorySize, LDS_TOTAL) != hipSuccess) { grid = -1; return; }
        grid = cus;
    }
    if (grid < 0) return;
    (void)hipMemsetAsync(p.bar, 0, XCD_BAR_WORDS * sizeof(unsigned), stream);
    hipLaunchKernelGGL(k_mega, dim3(grid), dim3(NTHR), LDS_TOTAL, stream, p);
}
```

```cpp
#include <hip/hip_runtime.h>
#include <stdint.h>
#include <cstdio>

typedef unsigned short bf16_t;
typedef short bf16x8 __attribute__((ext_vector_type(8)));
typedef float f32x4 __attribute__((ext_vector_type(4)));
typedef float f32x2 __attribute__((ext_vector_type(2)));
typedef float f32x16 __attribute__((ext_vector_type(16)));
typedef unsigned u32x4 __attribute__((ext_vector_type(4)));
typedef unsigned u32x2 __attribute__((ext_vector_type(2)));
#define LAS __attribute__((address_space(3)))

__device__ __forceinline__ bf16_t f2bf(float f) { unsigned u = __float_as_uint(f); u += 0x7FFFu + ((u >> 16) & 1u); return (bf16_t)(u >> 16); }
__device__ __forceinline__ float bf2f(bf16_t b) { return __uint_as_float(((unsigned)b) << 16); }
typedef __bf16 bf16v2_t __attribute__((ext_vector_type(2)));
__device__ __forceinline__ unsigned pk2(float lo, float hi) { f32x2 f = {lo, hi}; bf16v2_t b = __builtin_convertvector(f, bf16v2_t); return __builtin_bit_cast(unsigned, b); }
__device__ __forceinline__ float bflo(unsigned w) { return __uint_as_float(w << 16); }
__device__ __forceinline__ float bfhi(unsigned w) { return __uint_as_float(w & 0xFFFF0000u); }

__device__ __forceinline__ int ltid() { int t = (int)__builtin_amdgcn_workitem_id_x(); asm volatile("" : "+v"(t)); return t; }
__device__ __forceinline__ int lbid() { int b = (int)__builtin_amdgcn_workgroup_id_x(); asm volatile("" : "+s"(b)); return b; }
constexpr int D = 1024, SEQ = 8192, NTOK = 16384, INC = 2816;
constexpr int PN = 2304;
constexpr int C_QA = 0, C_KA = 384, C_PB = 512, C_QC = 1536, C_KC = 1920;
constexpr int VT_LD = NTOK;
constexpr float ALPHA = 1.41421356237f;
constexpr int NTHR = 512;

struct MegaP {
    const float *x, *ln0_g, *ln0_b, *w_in, *w_out, *sinks, *rel_bias, *shift_mu, *decay_w0, *decay_up, *iclr_a0, *iclr_up, *gate_up, *k_k, *k_a, *r_k, *lnx_g, *lnx_b,
                *ln1_g, *ln1_b, *router_w, *router_bias, *w_gate, *w_up, *w_down, *ln2_g, *ln2_b;
    float* out;
    bf16_t *H, *PROJN, *VT, *MIX, *Y1, *H1, *ACT, *F, *WIN_T, *WOUT_T, *W1_T, *WD_T, *DUP_T, *IUP_T, *GUP_T;
    char* RWG; int* cnt; int* list_tok; float* list_w; unsigned* bar;
};
typedef const MegaP __attribute__((address_space(4)))* KP;
__device__ __forceinline__ KP kparams_l() { unsigned long long a = (unsigned long long)__builtin_amdgcn_kernarg_segment_ptr(); asm volatile("" : "+s"(a)); return (KP)a; }

__device__ __forceinline__ int perm16(int i) { return (i & 3) | ((i & 4) << 1) | ((i & 8) >> 1); }
__device__ __forceinline__ int vt_pos(int t) { return (t & ~15) | perm16(t & 15); }

__device__ __forceinline__ float lane_read(float v, int src_lane) { return __int_as_float(__builtin_amdgcn_ds_bpermute(src_lane << 2, __float_as_int(v))); }
__device__ __forceinline__ float shx(float v, int m, int lane) { return lane_read(v, lane ^ m); }
__device__ __forceinline__ float wave_sum(float v, int lane) {
#pragma unroll
    for (int o = 32; o > 0; o >>= 1) v += shx(v, o, lane);
    return v;
}
__device__ __forceinline__ float sigmoidf_(float x) { return 1.0f / (1.0f + __expf(-x)); }

struct ConvP { const float *w_in, *w_out, *w_gate, *w_up, *w_down, *decay_up, *iclr_up, *gate_up; bf16_t *WIN_T, *WOUT_T, *W1_T, *WD_T, *DUP_T, *IUP_T, *GUP_T; };
constexpr int CONV_UNITS = 704 + 256 + 2048 + 1024 + 16;
__device__ __forceinline__ int orig_col(int n) { return n < 512 ? n : (n < 2304 ? n + 128 : (n < 2432 ? n - 2304 + 512 : n)); }
__device__ __forceinline__ void conv_unit(const ConvP& P, int u, float* tile  ) {
    const float* src; int ld_src, col0, k0; bf16_t* dst; int ld_dst;
    if (u < 704) { const int nt = u >> 4, kt = u & 15; src = P.w_in; ld_src = INC; col0 = orig_col(nt * 64); k0 = kt * 64; dst = P.WIN_T + (size_t)nt * 64 * 1024; ld_dst = 1024; }
    else if (u < 960) { const int v = u - 704, nt = v >> 4, kt = v & 15; src = P.w_out; ld_src = 1024; col0 = nt * 64; k0 = kt * 64; dst = P.WOUT_T + (size_t)nt * 64 * 1024; ld_dst = 1024; }
    else if (u < 3008) { const int v = u - 960, e = v >> 7, r = v & 127, nt = r >> 4, kt = r & 15, j0 = nt * 64, ct = j0 >> 8, jj = j0 & 255;
        src = (jj < 128 ? P.w_gate : P.w_up) + (size_t)e * 1024 * 256; ld_src = 256; col0 = ct * 128 + (jj & 127); k0 = kt * 64; dst = P.W1_T + (size_t)e * 512 * 1024 + (size_t)j0 * 1024; ld_dst = 1024; }
    else if (u >= 4032) { const int v = u - 4032;
        if (v < 4) { src = P.decay_up; ld_src = 256; col0 = v * 64; k0 = 0; dst = P.DUP_T + (size_t)v * 64 * 64; ld_dst = 64; }
        else if (v < 8) { src = P.iclr_up; ld_src = 256; col0 = (v - 4) * 64; k0 = 0; dst = P.IUP_T + (size_t)(v - 4) * 64 * 64; ld_dst = 64; }
        else { const int w = v - 8; src = P.gate_up; ld_src = 256; col0 = (w >> 1) * 64; k0 = (w & 1) * 64; dst = P.GUP_T + (size_t)(w >> 1) * 64 * 128; ld_dst = 128; } }
    else { const int v = u - 3008, e = v >> 6, r = v & 63, nt = r >> 2, kt = r & 3; src = P.w_down + (size_t)e * 256 * 1024; ld_src = 1024; col0 = nt * 64; k0 = kt * 64; dst = P.WD_T + (size_t)e * 1024 * 256 + (size_t)nt * 64 * 256; ld_dst = 256; }
    const int tid = ltid();
    { const int ty = tid >> 4, tx = tid & 15;
#pragma unroll
      for (int rr = 0; rr < 2; ++rr) { const int k = ty + 32 * rr; const f32x4 v = *(const f32x4*)(src + (size_t)(k0 + k) * ld_src + col0 + 4 * tx);
          tile[k * 65 + 4 * tx + 0] = v[0]; tile[k * 65 + 4 * tx + 1] = v[1]; tile[k * 65 + 4 * tx + 2] = v[2]; tile[k * 65 + 4 * tx + 3] = v[3]; } }
    __syncthreads();
    { const int n = tid >> 3, kc = (tid & 7) * 8; u32x4 w;
      w[0] = pk2(tile[(kc + 0) * 65 + n], tile[(kc + 1) * 65 + n]); w[1] = pk2(tile[(kc + 2) * 65 + n], tile[(kc + 3) * 65 + n]);
      w[2] = pk2(tile[(kc + 4) * 65 + n], tile[(kc + 5) * 65 + n]); w[3] = pk2(tile[(kc + 6) * 65 + n], tile[(kc + 7) * 65 + n]);
      *(u32x4*)(dst + (size_t)n * ld_dst + k0 + kc) = w; }
    __syncthreads();
}

__device__ __forceinline__ void ln_finish_store(const float (&v)[16], const float* __restrict__ g, const float* __restrict__ b, int lane, bf16_t* outb, float* outf) {
    float s = 0.f;
#pragma unroll
    for (int i = 0; i < 16; ++i) s += v[i];
    const float mu = wave_sum(s, lane) * (1.0f / D);
    float q = 0.f;
#pragma unroll
    for (int i = 0; i < 16; ++i) { const float d = v[i] - mu; q += d * d; }
    const float rs = rsqrtf(wave_sum(q, lane) * (1.0f / D) + 1e-5f);
#pragma unroll
    for (int i = 0; i < 4; ++i) { const int col = lane * 4 + 256 * i; const f32x4 gv = *(const f32x4*)(g + col), bv = *(const f32x4*)(b + col);
        float o[4];
#pragma unroll
        for (int j = 0; j < 4; ++j) o[j] = (v[4 * i + j] - mu) * rs * gv[j] + bv[j];
        if (outb) { u32x2 w; w[0] = pk2(o[0], o[1]); w[1] = pk2(o[2], o[3]); *(u32x2*)(outb + col) = w; }
        if (outf) { *(f32x4*)(outf + col) = (f32x4){o[0], o[1], o[2], o[3]}; } }
}

namespace pg8 {
constexpr int BM = 256, BK = 64, HALF = 128, HTB = HALF * BK * 2, STAGE_BYTES = 8 * HTB, NXCD = 8, WGM = 8;
__device__ __forceinline__ int lds_byte(int r, int c) { const int st = (r >> 4) * 2 + (c >> 5), rr = r & 15, cc = c & 31, ob = rr * 64 + cc * 2; return st * 1024 + (ob ^ (((ob >> 9) & 1) << 5)); }
__device__ __forceinline__ void stage_rc(int b, int& R, int& C) { const int st = b / 1024, sb = b % 1024, swz = sb ^ (((sb >> 9) & 1) << 5); R = (st >> 1) * 16 + swz / 64; C = (st & 1) * 32 + (swz % 64) / 2; }
__device__ __forceinline__ int perm32(int rho) { const int n = rho >> 4, i = rho & 15; return 8 * (i >> 2) + 4 * n + (i & 3); }
struct Unit { const char* a; const char* b; int row0, col0, kind, aux, n; };
__device__ __forceinline__ void tile_of(int L, int nM, int nN, int& pm, int& pn) {
    const int nwg = nM * nN; int wgid = L;
    { const int q = nwg / NXCD, r = nwg % NXCD, xcd = wgid % NXCD, off = wgid / NXCD; wgid = (xcd < r ? xcd * (q + 1) : r * (q + 1) + (xcd - r) * q) + off; }
    const int nig = WGM * nN, gid = wgid / nig, fm = gid * WGM, gsz = (nM - fm) < WGM ? (nM - fm) : WGM;
    pm = fm + ((wgid % nig) % gsz); pn = (wgid % nig) / gsz;
}
template <class Epi, class Sched, bool GATHER = false>
__device__ __forceinline__ void gemm_phase(LAS unsigned char* lds, const int K, const Sched& S, const Epi& E) {
    const int tid = ltid(), wid = __builtin_amdgcn_readfirstlane(tid >> 6), lane = tid & 63, wr = wid >> 2, wc = wid & 3, fr = lane & 15, fq = lane >> 4;
    const int nt = K / BK;
    unsigned voffB[2], vAc[2][2], vAn[2][2]; int stR[2], stC[2];
    const size_t kstep = (size_t)(BK * 2);
    const size_t hstep = (size_t)HALF * K * 2;
#pragma unroll
    for (int i = 0; i < 2; ++i) { int R, C; stage_rc(tid * 16 + i * 8192, R, C); const int Rb = Epi::PERM ? ((R & ~31) + perm32(R & 31)) : R; stR[i] = R; stC[i] = C;
        voffB[i] = (unsigned)(Rb * K + C) * 2u;
#pragma unroll
        for (int hf = 0; hf < 2; ++hf) { vAc[hf][i] = (unsigned)(R * K + C) * 2u + (unsigned)(hf * hstep); vAn[hf][i] = vAc[hf][i]; } }
    const unsigned ldsw = (unsigned)wid * 1024u;
    const int aoff = lds_byte(wr * 64 + fr, fq * 8), boff = lds_byte(wc * 32 + fr, fq * 8);
#define PG8_SA(b, h) (((b) * 2 + (h)) * HTB)
#define PG8_SB(b, h) ((4 + (b) * 2 + (h)) * HTB)
#define PG8_STAGE(bufoff, gbase, voff) do { _Pragma("unroll") for (int _i = 0; _i < 2; ++_i) \
        __builtin_amdgcn_global_load_lds((const unsigned*)((const char*)(gbase) + (voff)[_i]), (LAS unsigned*)(lds + (bufoff) + ldsw + _i * 8192), 16, 0, 0); } while (0)
#define PG8_LDA(dst, b, h) do { _Pragma("unroll") for (int m = 0; m < 4; ++m) _Pragma("unroll") for (int k = 0; k < 2; ++k) dst[m][k] = *(const LAS bf16x8*)(lds + PG8_SA(b, h) + aoff + m * 2048 + k * 1024); } while (0)
#define PG8_LDB(dst, b, h) do { _Pragma("unroll") for (int n = 0; n < 2; ++n) _Pragma("unroll") for (int k = 0; k < 2; ++k) dst[n][k] = *(const LAS bf16x8*)(lds + PG8_SB(b, h) + boff + n * 2048 + k * 1024); } while (0)
#define PG8_MMA(ai, bj, At, Bt) do { __builtin_amdgcn_s_setprio(1); _Pragma("unroll") for (int m = 0; m < 4; ++m) _Pragma("unroll") for (int n = 0; n < 2; ++n) _Pragma("unroll") for (int k = 0; k < 2; ++k) \
        acc[ai][bj][m][n] = __builtin_amdgcn_mfma_f32_16x16x32_bf16(Bt[n][k], At[m][k], acc[ai][bj][m][n], 0, 0, 0); __builtin_amdgcn_s_setprio(0); } while (0)
#define PG8_WAIT_V(n) asm volatile("s_waitcnt vmcnt(" #n ")" ::: "memory")
#define PG8_WAIT_L(n) asm volatile("s_waitcnt lgkmcnt(" #n ")" ::: "memory")
#define PG8_BAR __builtin_amdgcn_s_barrier()
#define PG8_SCHED __builtin_amdgcn_sched_barrier(0)
    Unit cur, nxt; int ui = 0;
    if (!S.next(0, cur)) return;
    f32x4 acc[2][2][4][2];
#pragma unroll
    for (int a = 0; a < 2; ++a)
#pragma unroll
        for (int b = 0; b < 2; ++b)
#pragma unroll
            for (int m = 0; m < 4; ++m)
#pragma unroll
                for (int n = 0; n < 2; ++n) acc[a][b][m][n] = (f32x4){0.f, 0.f, 0.f, 0.f};
    bf16x8 At[4][2], B0[2][2], B1[2][2];
    const char* cA = cur.a; const char* cB = cur.b;
    if constexpr (GATHER) {
#pragma unroll
        for (int i = 0; i < 2; ++i)
#pragma unroll
            for (int hf = 0; hf < 2; ++hf) { vAc[hf][i] = S.a_off(cur, hf * HALF + stR[i]) + (unsigned)stC[i] * 2u; vAn[hf][i] = vAc[hf][i]; }
    }
    PG8_STAGE(PG8_SB(0, 0), cB, voffB); PG8_STAGE(PG8_SA(0, 0), cA, vAc[0]); PG8_STAGE(PG8_SB(0, 1), cB + hstep, voffB); PG8_STAGE(PG8_SA(0, 1), cA, vAc[1]);
    if (wr == 1) PG8_BAR;
    PG8_WAIT_V(4); PG8_BAR;
    PG8_STAGE(PG8_SB(1, 0), cB + kstep, voffB); PG8_STAGE(PG8_SA(1, 0), cA + kstep, vAc[0]); PG8_STAGE(PG8_SB(1, 1), cB + hstep + kstep, voffB);
    PG8_WAIT_V(6); PG8_BAR;
    for (;;) {
        const bool has_next = S.next(ui + 1, nxt);
        const char* nA = has_next ? nxt.a : cA; const char* nB = has_next ? nxt.b : cB;
        if constexpr (GATHER) {
            if (has_next) {
#pragma unroll
                for (int i = 0; i < 2; ++i)
#pragma unroll
                    for (int hf = 0; hf < 2; ++hf) vAn[hf][i] = S.a_off(nxt, hf * HALF + stR[i]) + (unsigned)stC[i] * 2u;
            }
        }
        for (int t = 0; t < nt; t += 2) {
            const bool last = (t == nt - 2);
            const char* a1 = cA + (size_t)(t + 1) * kstep;
            const char* a2 = last ? nA : cA + (size_t)(t + 2) * kstep; const char* b2 = last ? nB : cB + (size_t)(t + 2) * kstep;
            const char* a3 = a2 + kstep; const char* b3 = b2 + kstep;
            unsigned vA2[2][2];
#pragma unroll
            for (int i = 0; i < 2; ++i)
#pragma unroll
                for (int hf = 0; hf < 2; ++hf) vA2[hf][i] = (GATHER && last) ? vAn[hf][i] : vAc[hf][i];
            PG8_LDB(B0, 0, 0); PG8_SCHED; PG8_LDA(At, 0, 0); PG8_STAGE(PG8_SA(1, 1), a1, vAc[1]);
            PG8_WAIT_L(8); PG8_BAR; PG8_WAIT_L(0); PG8_MMA(0, 0, At, B0); PG8_BAR; PG8_SCHED;
            PG8_LDB(B1, 0, 1); PG8_STAGE(PG8_SB(0, 0), b2, voffB);
            PG8_BAR; PG8_WAIT_L(0); PG8_MMA(0, 1, At, B1); PG8_BAR;
            PG8_LDA(At, 0, 1); PG8_STAGE(PG8_SA(0, 0), a2, vA2[0]);
            PG8_BAR; PG8_WAIT_L(0); PG8_MMA(1, 0, At, B0); PG8_BAR; PG8_SCHED;
            PG8_STAGE(PG8_SB(0, 1), b2 + hstep, voffB);
            PG8_WAIT_V(6); PG8_BAR; PG8_MMA(1, 1, At, B1); PG8_BAR;
            PG8_LDB(B0, 1, 0); PG8_SCHED; PG8_LDA(At, 1, 0); PG8_STAGE(PG8_SA(0, 1), a2, vA2[1]);
            PG8_WAIT_L(8); PG8_BAR; PG8_WAIT_L(0); PG8_MMA(0, 0, At, B0); PG8_BAR; PG8_SCHED;
            PG8_LDB(B1, 1, 1); PG8_STAGE(PG8_SB(1, 0), b3, voffB);
            PG8_BAR; PG8_WAIT_L(0); PG8_MMA(0, 1, At, B1); PG8_BAR;
            PG8_LDA(At, 1, 1); PG8_STAGE(PG8_SA(1, 0), a3, vA2[0]);
            PG8_BAR; PG8_WAIT_L(0); PG8_MMA(1, 0, At, B0); PG8_BAR; PG8_SCHED;
            PG8_STAGE(PG8_SB(1, 1), b3 + hstep, voffB);
            PG8_WAIT_V(6); PG8_BAR; PG8_MMA(1, 1, At, B1); PG8_BAR;
        }
        { const int tz = ltid(), wz = tz >> 6, lz = tz & 63; E(acc, cur, wz >> 2, wz & 3, lz & 15, lz >> 4); }
        if (!has_next) break;
#pragma unroll
        for (int a = 0; a < 2; ++a)
#pragma unroll
            for (int b = 0; b < 2; ++b)
#pragma unroll
                for (int m = 0; m < 4; ++m)
#pragma unroll
                    for (int n = 0; n < 2; ++n) acc[a][b][m][n] = (f32x4){0.f, 0.f, 0.f, 0.f};
        cur = nxt; cA = nA; cB = nB; ++ui;
#pragma unroll
        for (int i = 0; i < 2; ++i)
#pragma unroll
            for (int hf = 0; hf < 2; ++hf) vAc[hf][i] = vAn[hf][i];
    }
    PG8_WAIT_V(0);
    if (wr == 0) PG8_BAR;
    PG8_BAR;
#undef PG8_SA
#undef PG8_SB
#undef PG8_STAGE
#undef PG8_LDA
#undef PG8_LDB
#undef PG8_MMA
#undef PG8_WAIT_V
#undef PG8_WAIT_L
#undef PG8_BAR
#undef PG8_SCHED
}
}

struct SchedProjN {
    const char* H; const char* W; int G, c;
    __device__ __forceinline__ bool next(int i, pg8::Unit& u) const {
        const int L = i * G + c; if (L >= 576) return false; int pm, pn;
        pg8::tile_of(L, 64, 9, pm, pn); u.a = H + (size_t)pm * 256 * 2048; u.b = W + (size_t)pn * 256 * 2048; u.kind = 0;
        u.row0 = pm * 256; u.col0 = pn * 256; u.aux = 0; u.n = 0; return true;
    }
};
struct SchedProjV {
    const char* H; const char* W; int G, c;
    __device__ __forceinline__ bool next(int i, pg8::Unit& u) const {
        const int L = i * G + c - 64; if (L < 0 || L >= 128 || i > 0) return false; int pm, pn;
        pg8::tile_of(L, 2, 64, pm, pn); u.a = W + (size_t)(2304 + pm * 256) * 2048; u.b = H + (size_t)pn * 256 * 2048; u.kind = 1;
        u.row0 = pm * 256; u.col0 = pn * 256; u.aux = 0; u.n = 0; return true;
    }
};
struct EpiProjN {
    static constexpr bool PERM = true;
    bf16_t* projn;
    __device__ __forceinline__ void operator()(const f32x4 (&acc)[2][2][4][2], const pg8::Unit& u, int wr, int wc, int fr, int fq) const {
        const int row0 = u.row0 + wr * 64 + fr, col0 = u.col0 + wc * 32 + 8 * fq;
#pragma unroll
        for (int ai = 0; ai < 2; ++ai)
#pragma unroll
            for (int m = 0; m < 4; ++m) { bf16_t* rowp = projn + (size_t)(row0 + ai * 128 + m * 16) * PN + col0;
#pragma unroll
                for (int bj = 0; bj < 2; ++bj) { const f32x4 v0 = acc[ai][bj][m][0], v1 = acc[ai][bj][m][1]; u32x4 w;
                    w[0] = pk2(v0[0], v0[1]); w[1] = pk2(v0[2], v0[3]); w[2] = pk2(v1[0], v1[1]); w[3] = pk2(v1[2], v1[3]);
                    *(u32x4*)(rowp + bj * 128) = w; } }
    }
};
struct EpiProjV {
    static constexpr bool PERM = true;
    bf16_t* vt;
    __device__ __forceinline__ void operator()(const f32x4 (&acc)[2][2][4][2], const pg8::Unit& u, int wr, int wc, int fr, int fq) const {
        const int row0 = u.row0 + wr * 64 + fr;
#pragma unroll
        for (int ai = 0; ai < 2; ++ai)
#pragma unroll
            for (int m = 0; m < 4; ++m) { bf16_t* rowp = vt + (size_t)(row0 + ai * 128 + m * 16) * VT_LD + (u.col0 + wc * 32 + 16 * (fq >> 1) + 4 * (fq & 1));
#pragma unroll
                for (int bj = 0; bj < 2; ++bj)
#pragma unroll
                    for (int n = 0; n < 2; ++n) { const f32x4 v = acc[ai][bj][m][n]; u32x2 w; w[0] = pk2(v[0], v[1]); w[1] = pk2(v[2], v[3]);
                        *(u32x2*)(rowp + bj * 128 + 8 * n) = w; } }
    }
};
__device__ __forceinline__ void phase_proj(LAS unsigned char* lds, const bf16_t* H, const bf16_t* WIN_T, bf16_t* projn, bf16_t* vt, int G, int c) {
    { SchedProjN S{(const char*)H, (const char*)WIN_T, G, c}; EpiProjN E{projn}; pg8::gemm_phase<EpiProjN, SchedProjN>(lds, 1024, S, E); }
    { SchedProjV S{(const char*)H, (const char*)WIN_T, G, c}; EpiProjV E{vt}; pg8::gemm_phase<EpiProjV, SchedProjV>(lds, 1024, S, E); }
}
struct SchedWout {
    const char* A; const char* W; int G, c;
    __device__ __forceinline__ bool next(int i, pg8::Unit& u) const {
        const int L = i * G + c; if (L >= 256) return false; int pm, pn; pg8::tile_of(L, 64, 4, pm, pn);
        u.a = A + (size_t)pm * 256 * 2048; u.b = W + (size_t)pn * 256 * 2048; u.row0 = pm * 256; u.col0 = pn * 256; u.kind = 0; u.aux = 0; u.n = 0; return true;
    }
};
struct EpiWout {
    static constexpr bool PERM = true;
    const bf16_t* H; bf16_t* Y1;
    __device__ __forceinline__ void operator()(const f32x4 (&acc)[2][2][4][2], const pg8::Unit& u, int wr, int wc, int fr, int fq) const {
        const int row0 = u.row0 + wr * 64 + fr, col0 = u.col0 + wc * 32 + 8 * fq;
#pragma unroll
        for (int ai = 0; ai < 2; ++ai)
#pragma unroll
            for (int m = 0; m < 4; ++m) { const size_t off = (size_t)(row0 + ai * 128 + m * 16) * D + col0;
#pragma unroll
                for (int bj = 0; bj < 2; ++bj) { const f32x4 v0 = acc[ai][bj][m][0], v1 = acc[ai][bj][m][1]; const u32x4 h = *(const u32x4*)(H + off + bj * 128); u32x4 w;
                    w[0] = pk2(ALPHA * bflo(h[0]) + v0[0], ALPHA * bfhi(h[0]) + v0[1]); w[1] = pk2(ALPHA * bflo(h[1]) + v0[2], ALPHA * bfhi(h[1]) + v0[3]);
                    w[2] = pk2(ALPHA * bflo(h[2]) + v1[0], ALPHA * bfhi(h[2]) + v1[1]); w[3] = pk2(ALPHA * bflo(h[3]) + v1[2], ALPHA * bfhi(h[3]) + v1[3]);
                    *(u32x4*)(Y1 + off + bj * 128) = w; } }
    }
};

#define MFMA32(a, b, c) __builtin_amdgcn_mfma_f32_32x32x16_bf16((a), (b), (c), 0, 0, 0)
template <int S_> __device__ __forceinline__ bf16x8 pack8(const f32x16& x) {
    u32x4 p; p[0] = pk2(x[8 * S_], x[8 * S_ + 1]); p[1] = pk2(x[8 * S_ + 2], x[8 * S_ + 3]); p[2] = pk2(x[8 * S_ + 4], x[8 * S_ + 5]); p[3] = pk2(x[8 * S_ + 6], x[8 * S_ + 7]);
    return __builtin_bit_cast(bf16x8, p);
}
__device__ __forceinline__ f32x16 zero16() { f32x16 z;
#pragma unroll
    for (int i = 0; i < 16; ++i) z[i] = 0.f;
    return z; }
constexpr float LOG2E = 1.4426950408889634f;
__device__ __forceinline__ int t5_bucket(int dist) {
    if (dist < 16) return dist;
    int large = 16 + (int)(logf((float)dist * (1.0f / 16.0f)) / 2.0794415416798357f * 16.0f);
    return large < 31 ? large : 31;
}
__device__ __forceinline__ void attn_c_unit(const bf16_t* __restrict__ projn, const bf16_t* __restrict__ vt, bf16_t* __restrict__ mix, int b, int qt, int h, int lane) {
    const int q = lane & 31, hh = lane >> 5;
    const size_t tq = (size_t)b * SEQ + qt * 32 + q;
    bf16x8 qf[4];
#pragma unroll
    for (int s = 0; s < 4; ++s) qf[s] = *(const bf16x8*)(projn + tq * PN + C_QC + h * 64 + 16 * s + 8 * hh);
    bf16x8 tri[2];
#pragma unroll
    for (int s = 0; s < 2; ++s)
#pragma unroll
        for (int j = 0; j < 8; ++j) { const int kp = 16 * s + 8 * (j >> 2) + 4 * hh + (j & 3); tri[s][j] = (short)(kp > q ? 0x3F80 : 0); }
    f32x16 O0 = zero16(), O1 = zero16(); float carry = 0.f;
    const float c2 = 0.125f * LOG2E;
    for (int kt = qt; kt >= 0; --kt) {
        const size_t tk = (size_t)b * SEQ + kt * 32;
        bf16x8 kf[4];
#pragma unroll
        for (int s = 0; s < 4; ++s) kf[s] = *(const bf16x8*)(projn + (tk + q) * PN + C_KC + h * 64 + 16 * s + 8 * hh);
        bf16x8 vf[2][2];
#pragma unroll
        for (int s = 0; s < 2; ++s)
#pragma unroll
            for (int dt = 0; dt < 2; ++dt) vf[s][dt] = *(const bf16x8*)(vt + (size_t)(128 + h * 64 + dt * 32 + q) * VT_LD + tk + 16 * s + 8 * hh);
        f32x16 Z = zero16();
#pragma unroll
        for (int s = 0; s < 4; ++s) Z = MFMA32(kf[s], qf[s], Z);
        const bool diag = (kt == qt);
        f32x16 lk, lb;
#pragma unroll
        for (int r = 0; r < 16; ++r) {
            const float z = Z[r] * c2;
            const float sp = fmaxf(z, 0.f) + __builtin_amdgcn_logf(1.0f + __builtin_amdgcn_exp2f(-fabsf(z)));
            float l = -sp, bb = z - sp;
            if (diag) { const int krow = (r & 3) + 8 * (r >> 2) + 4 * hh; const bool valid = krow < q; l = valid ? l : 0.f; bb = valid ? bb : -1e30f; }
            lk[r] = l; lb[r] = bb;
        }
        f32x16 Sx;
#pragma unroll
        for (int r = 0; r < 16; ++r) Sx[r] = carry;
        Sx = MFMA32(tri[0], pack8<0>(lk), Sx);
        Sx = MFMA32(tri[1], pack8<1>(lk), Sx);
        f32x16 W; float tot = 0.f;
#pragma unroll
        for (int r = 0; r < 16; ++r) { W[r] = __builtin_amdgcn_exp2f(lb[r] + Sx[r]); tot += lk[r]; }
        tot += shx(tot, 32, lane);
        carry += tot;
        { const bf16x8 wf = pack8<0>(W); O0 = MFMA32(vf[0][0], wf, O0); O1 = MFMA32(vf[0][1], wf, O1); }
        { const bf16x8 wf = pack8<1>(W); O0 = MFMA32(vf[1][0], wf, O0); O1 = MFMA32(vf[1][1], wf, O1); }
        if (__builtin_amdgcn_ballot_w64(carry < -90.0f) == ~0ull) break;
    }
    bf16_t* op = mix + tq * D + 640 + h * 64 + 4 * hh;
#pragma unroll
    for (int g = 0; g < 4; ++g) {
        u32x2 w; w[0] = pk2(O0[4 * g], O0[4 * g + 1]); w[1] = pk2(O0[4 * g + 2], O0[4 * g + 3]); *(u32x2*)(op + 8 * g) = w;
        u32x2 w1; w1[0] = pk2(O1[4 * g], O1[4 * g + 1]); w1[1] = pk2(O1[4 * g + 2], O1[4 * g + 3]); *(u32x2*)(op + 32 + 8 * g) = w1;
    }
}
__device__ __forceinline__ void attn_a_unit(const bf16_t* __restrict__ projn, const bf16_t* __restrict__ vt, const float* __restrict__ sinks, const LAS float* biasL,
                                            bf16_t* __restrict__ mix, int b, int qt, int hq, int lane) {
    const int q = lane & 31, hh = lane >> 5, kv = hq / 3;
    const size_t tq = (size_t)b * SEQ + qt * 32 + q;
    bf16x8 qf[4];
#pragma unroll
    for (int s = 0; s < 4; ++s) qf[s] = *(const bf16x8*)(projn + tq * PN + C_QA + hq * 64 + 16 * s + 8 * hh);
    const float c2 = 0.125f * LOG2E;
    const float sink2 = sinks[hq] * LOG2E;
    f32x16 L[5]; float m2 = sink2;
#pragma unroll
    for (int i = 0; i < 5; ++i) {
        const int kt = qt - 4 + i;
        if (kt >= 0) {
            const size_t tk = (size_t)b * SEQ + kt * 32;
            bf16x8 kf[4];
#pragma unroll
            for (int s = 0; s < 4; ++s) kf[s] = *(const bf16x8*)(projn + (tk + q) * PN + C_KA + kv * 64 + 16 * s + 8 * hh);
            f32x16 Z = zero16();
#pragma unroll
            for (int s = 0; s < 4; ++s) Z = MFMA32(kf[s], qf[s], Z);
#pragma unroll
            for (int r = 0; r < 16; ++r) {
                const int krow = (r & 3) + 8 * (r >> 2) + 4 * hh; const int dist = (4 - i) * 32 + q - krow;
                const bool valid = (i == 0) ? (dist < 128) : ((i == 4) ? (dist >= 0) : true);
                const float l2 = valid ? Z[r] * c2 + biasL[hq * 128 + (dist & 127)] : -INFINITY;
                L[i][r] = l2; m2 = fmaxf(m2, l2);
            }
        } else {
#pragma unroll
            for (int r = 0; r < 16; ++r) L[i][r] = -INFINITY;
        }
    }
    m2 = fmaxf(m2, shx(m2, 32, lane));
    float den = 0.f;
#pragma unroll
    for (int i = 0; i < 5; ++i)
#pragma unroll
        for (int r = 0; r < 16; ++r) { const float p = __builtin_amdgcn_exp2f(L[i][r] - m2); L[i][r] = p; den += p; }
    den += shx(den, 32, lane);
    den += __builtin_amdgcn_exp2f(sink2 - m2);
    f32x16 O0 = zero16(), O1 = zero16();
#pragma unroll
    for (int i = 0; i < 5; ++i) {
        const int kt = qt - 4 + i;
        if (kt >= 0) {
            const size_t tk = (size_t)b * SEQ + kt * 32;
            const bf16_t* vp = vt + (size_t)(kv * 64 + q) * VT_LD + tk + 8 * hh;
            const bf16x8 v00 = *(const bf16x8*)(vp), v01 = *(const bf16x8*)(vp + (size_t)32 * VT_LD), v10 = *(const bf16x8*)(vp + 16), v11 = *(const bf16x8*)(vp + (size_t)32 * VT_LD + 16);
            { const bf16x8 pf = pack8<0>(L[i]); O0 = MFMA32(v00, pf, O0); O1 = MFMA32(v01, pf, O1); }
            { const bf16x8 pf = pack8<1>(L[i]); O0 = MFMA32(v10, pf, O0); O1 = MFMA32(v11, pf, O1); }
        }
    }
    const float inv = 1.0f / den;
    bf16_t* op = mix + tq * D + hq * 64 + 4 * hh;
#pragma unroll
    for (int g = 0; g < 4; ++g) {
        u32x2 w; w[0] = pk2(O0[4 * g] * inv, O0[4 * g + 1] * inv); w[1] = pk2(O0[4 * g + 2] * inv, O0[4 * g + 3] * inv); *(u32x2*)(op + 8 * g) = w;
        u32x2 w1; w1[0] = pk2(O1[4 * g] * inv, O1[4 * g + 1] * inv); w1[1] = pk2(O1[4 * g + 2] * inv, O1[4 * g + 3] * inv); *(u32x2*)(op + 32 + 8 * g) = w1;
    }
}
constexpr int ATT_UNITS = 2 * 256 * 6;
__device__ __forceinline__ void phase_attn(LAS unsigned char* lds, const bf16_t* projn, const bf16_t* vt, const float* sinks, const float* rel_bias, bf16_t* mix, int wave0, int nwaves) {
    LAS float* biasL = (LAS float*)lds;
    for (int i = ltid(); i < 768; i += NTHR) { const int hq = i >> 7, dist = i & 127; biasL[i] = rel_bias[t5_bucket(dist) * 6 + hq] * LOG2E; }
    __syncthreads();
    const int lane = ltid() & 63;
    for (int u = wave0; u < 2 * ATT_UNITS; u += nwaves) {
        const int v = u >= ATT_UNITS ? u - ATT_UNITS : u; const int h = v % 6, qt = (v / 6) & 255, b = v / 1536;
        if (u < ATT_UNITS) attn_c_unit(projn, vt, mix, b, qt, h, lane); else attn_a_unit(projn, vt, sinks, biasL, mix, b, qt, h, lane);
    }
}

#define MFMA16(a, b, c) __builtin_amdgcn_mfma_f32_16x16x32_bf16((a), (b), (c), 0, 0, 0)
constexpr int LDW = 72;
constexpr int RBUF = 64 * LDW * 2;
constexpr int RW_LDS = 14 * RBUF + 4096 + 256;
struct RwkvW { const float *shift_mu, *decay_w0, *iclr_a0, *k_k, *k_a, *r_k, *lnx_g, *lnx_b; const bf16_t *DUP_T, *IUP_T, *GUP_T; };
struct RwkvG { bf16_t* PT; float* QT; bf16_t* GT; bf16_t* YL; bf16_t* S0; bf16_t* G; float* BON; };
constexpr size_t RWG_PT = 0, RWG_QT = RWG_PT + (size_t)1024 * 8192, RWG_GT = RWG_QT + (size_t)1024 * 16384, RWG_YL = RWG_GT + (size_t)1024 * 8192,
                 RWG_S0 = RWG_YL + (size_t)1024 * 8192, RWG_G = RWG_S0 + (size_t)1024 * 8192, RWG_BON = RWG_G + (size_t)NTOK * 256 * 2, RWG_END = RWG_BON + (size_t)NTOK * 4 * 4;

template <class F> __device__ __forceinline__ void mm64(const LAS bf16_t* X, const LAS bf16_t* Y, int wid, int lane, F epi) {
    const int rt = wid >> 1, chh = wid & 1, fr = lane & 15, fq = lane >> 4;
    f32x4 a0 = {0.f, 0.f, 0.f, 0.f}, a1 = {0.f, 0.f, 0.f, 0.f};
#pragma unroll
    for (int ks = 0; ks < 2; ++ks) {
        const bf16x8 a = *(const LAS bf16x8*)(X + (16 * rt + fr) * LDW + 32 * ks + 8 * fq);
        const bf16x8 b0 = *(const LAS bf16x8*)(Y + (32 * chh + fr) * LDW + 32 * ks + 8 * fq);
        const bf16x8 b1 = *(const LAS bf16x8*)(Y + (32 * chh + 16 + fr) * LDW + 32 * ks + 8 * fq);
        a0 = MFMA16(a, b0, a0); a1 = MFMA16(a, b1, a1);
    }
#pragma unroll
    for (int r = 0; r < 4; ++r) { epi(16 * rt + 4 * fq + r, 32 * chh + fr, a0[r]); epi(16 * rt + 4 * fq + r, 32 * chh + 16 + fr, a1[r]); }
}
__device__ __forceinline__ void shifted8(const bf16_t* cur, bool hasprev, const float* mu, float (&x)[8]) {
    const u32x4 cw = *(const u32x4*)cur; u32x4 pw = {0u, 0u, 0u, 0u}; if (hasprev) pw = *(const u32x4*)(cur - PN);
    const f32x4 m0 = *(const f32x4*)mu, m1 = *(const f32x4*)(mu + 4);
#pragma unroll
    for (int i = 0; i < 4; ++i) { const float c0 = bflo(cw[i]), c1 = bfhi(cw[i]), p0 = bflo(pw[i]), p1 = bfhi(pw[i]); const float ma = i < 2 ? m0[2 * i] : m1[2 * i - 4], mb = i < 2 ? m0[2 * i + 1] : m1[2 * i - 3];
        x[2 * i] = c0 + (p0 - c0) * ma; x[2 * i + 1] = c1 + (p1 - c1) * mb; }
}
__device__ __forceinline__ bf16x8 pack8f(const float (&x)[8]) { u32x4 p; p[0] = pk2(x[0], x[1]); p[1] = pk2(x[2], x[3]); p[2] = pk2(x[4], x[5]); p[3] = pk2(x[6], x[7]); return __builtin_bit_cast(bf16x8, p); }
__device__ __forceinline__ float fast_tanh(float x) { const float e = __expf(-2.0f * fabsf(x)); const float t = (1.0f - e) / (1.0f + e); return x < 0.f ? -t : t; }

__device__ __forceinline__ void rwkv_prep_unit(LAS unsigned char* lds, const bf16_t* __restrict__ projn, const RwkvW& W, const RwkvG& Gp, int b, int c, int h) {
    const int tid = ltid(), wid = tid >> 6, lane = tid & 63, fr = lane & 15, fq = lane >> 4;
    const size_t tok0 = (size_t)b * SEQ + (size_t)c * 64; const bool first = (c == 0);
    const int uidx = (b * 128 + c) * 4 + h;
#define RB(i) ((LAS bf16_t*)(lds + (i) * RBUF))
    LAS float* LWs = (LAS float*)(lds + 8 * RBUF); LAS float* AAs = LWs + 64 * 65;
    LAS float* PART = (LAS float*)(lds + 14 * RBUF); LAS float* GCs = PART + 1024;
    {
        const int rt = wid >> 1, chh = wid & 1, t = 16 * rt + fr; const bool hasprev = !(first && t == 0);
        const bf16_t* cur = projn + (tok0 + t) * PN + C_PB;
        f32x4 aU[2], aA[2], aG[2];
#pragma unroll
        for (int n = 0; n < 2; ++n) { aU[n] = (f32x4){0.f, 0.f, 0.f, 0.f}; aA[n] = aU[n]; aG[n] = aU[n]; }
#pragma unroll
        for (int ks = 0; ks < 2; ++ks) {
            float x[8]; const int col = 768 + 32 * ks + 8 * fq; shifted8(cur + col, hasprev, W.shift_mu + col, x);
#pragma unroll
            for (int i = 0; i < 8; ++i) x[i] = fast_tanh(x[i]);
            const bf16x8 a = pack8f(x);
#pragma unroll
            for (int n = 0; n < 2; ++n) { const bf16x8 bb = *(const bf16x8*)(W.DUP_T + (size_t)(h * 64 + 32 * chh + 16 * n + fr) * 64 + 32 * ks + 8 * fq); aU[n] = MFMA16(a, bb, aU[n]); }
        }
#pragma unroll
        for (int ks = 0; ks < 2; ++ks) {
            float x[8]; const int col = 832 + 32 * ks + 8 * fq; shifted8(cur + col, hasprev, W.shift_mu + col, x);
            const bf16x8 a = pack8f(x);
#pragma unroll
            for (int n = 0; n < 2; ++n) { const bf16x8 bb = *(const bf16x8*)(W.IUP_T + (size_t)(h * 64 + 32 * chh + 16 * n + fr) * 64 + 32 * ks + 8 * fq); aA[n] = MFMA16(a, bb, aA[n]); }
        }
#pragma unroll
        for (int ks = 0; ks < 4; ++ks) {
            float x[8]; const int col = 896 + 32 * ks + 8 * fq; shifted8(cur + col, hasprev, W.shift_mu + col, x);
#pragma unroll
            for (int i = 0; i < 8; ++i) x[i] = sigmoidf_(x[i]);
            const bf16x8 a = pack8f(x);
#pragma unroll
            for (int n = 0; n < 2; ++n) { const bf16x8 bb = *(const bf16x8*)(W.GUP_T + (size_t)(h * 64 + 32 * chh + 16 * n + fr) * 128 + 32 * ks + 8 * fq); aG[n] = MFMA16(a, bb, aG[n]); }
        }
#pragma unroll
        for (int n = 0; n < 2; ++n)
#pragma unroll
            for (int r = 0; r < 4; ++r) { const int t_ = 16 * rt + 4 * fq + r, ch = 32 * chh + 16 * n + fr, cidx = h * 64 + ch;
                LWs[t_ * 65 + ch] = -0.6065306597f * sigmoidf_(aU[n][r] + W.decay_w0[cidx]);
                AAs[t_ * 65 + ch] = sigmoidf_(aA[n][r] + W.iclr_a0[cidx]);
                Gp.G[(tok0 + t_) * 256 + cidx] = f2bf(aG[n][r]); }
    }
    __syncthreads();
    {
        const int t = lane, cg = wid, col0 = h * 64 + cg * 8; const bool hasprev = !(first && t == 0);
        const bf16_t* cur = projn + (tok0 + t) * PN + C_PB;
        float r[8], k[8], v[8];
        shifted8(cur + col0, hasprev, W.shift_mu + col0, r); shifted8(cur + 256 + col0, hasprev, W.shift_mu + 256 + col0, k); shifted8(cur + 512 + col0, hasprev, W.shift_mu + 512 + col0, v);
        float lw[8], aa[8], L[8], LC[8], kk[8], km[8]; float ss = 0.f, bn = 0.f;
#pragma unroll
        for (int i = 0; i < 8; ++i) { lw[i] = LWs[t * 65 + cg * 8 + i]; aa[i] = AAs[t * 65 + cg * 8 + i]; }
#pragma unroll
        for (int i = 0; i < 8; ++i) { float x = lw[i];
#pragma unroll
            for (int o = 1; o < 64; o <<= 1) { const float n = lane_read(x, lane >= o ? lane - o : lane); if (lane >= o) x += n; }
            L[i] = x; LC[i] = lane_read(x, 63); }
#pragma unroll
        for (int i = 0; i < 8; ++i) { const int cidx = col0 + i; kk[i] = k[i] * W.k_k[cidx]; ss += kk[i] * kk[i]; km[i] = k[i] * (1.0f + (aa[i] - 1.0f) * W.k_a[cidx]); bn += r[i] * km[i] * W.r_k[cidx]; }
        PART[cg * 64 + t] = ss; PART[512 + cg * 64 + t] = bn;
        __syncthreads();
        float sst = 0.f, bnt = 0.f;
#pragma unroll
        for (int g = 0; g < 8; ++g) { sst += PART[g * 64 + t]; bnt += PART[512 + g * 64 + t]; }
        if (cg == 0) Gp.BON[(tok0 + t) * 4 + h] = bnt;
        const float rn = rsqrtf(fmaxf(sst, 1e-24f));
        float at[8], bt[8], kt[8], rt_[8], bh[8], kh[8];
#pragma unroll
        for (int i = 0; i < 8; ++i) { const float kkn = kk[i] * rn; const float g = __expf(L[i]), gp = __expf(L[i] - lw[i]), gi = __expf(-L[i]), ge = __expf(LC[i] - L[i]);
            at[i] = -kkn * gp; bt[i] = kkn * aa[i] * gi; kt[i] = km[i] * gi; rt_[i] = r[i] * g; bh[i] = kkn * aa[i] * ge; kh[i] = km[i] * ge; }
        *(LAS bf16x8*)(RB(0) + t * LDW + cg * 8) = pack8f(at); *(LAS bf16x8*)(RB(1) + t * LDW + cg * 8) = pack8f(bt);
        *(LAS bf16x8*)(RB(2) + t * LDW + cg * 8) = pack8f(kt); *(LAS bf16x8*)(RB(3) + t * LDW + cg * 8) = pack8f(rt_);
#pragma unroll
        for (int i = 0; i < 8; ++i) { RB(4)[(cg * 8 + i) * LDW + t] = f2bf(at[i]); RB(5)[(cg * 8 + i) * LDW + t] = f2bf(bh[i]); RB(6)[(cg * 8 + i) * LDW + t] = f2bf(v[i]); RB(7)[(cg * 8 + i) * LDW + t] = f2bf(kh[i]); }
        if (t == 63) {
#pragma unroll
            for (int i = 0; i < 8; ++i) GCs[cg * 8 + i] = __expf(LC[i]); }
    }
    __syncthreads();
    mm64(RB(1), RB(0), wid, lane, [&](int j, int t, float v) { const float m = j < t ? v : 0.f; RB(8)[j * LDW + t] = f2bf(m + (j == t ? 1.0f : 0.f)); RB(9)[j * LDW + t] = f2bf(m); RB(10)[t * LDW + j] = f2bf(m); });
    mm64(RB(2), RB(0), wid, lane, [&](int j, int t, float v) { RB(11)[j * LDW + t] = f2bf(j < t ? v : 0.f); });
    mm64(RB(3), RB(1), wid, lane, [&](int t, int i, float v) { RB(12)[t * LDW + i] = f2bf(i <= t ? v : 0.f); });
    mm64(RB(3), RB(2), wid, lane, [&](int t, int j, float v) { RB(13)[t * LDW + j] = f2bf(j <= t ? v : 0.f); });
    __syncthreads();
    auto sq = [&](int sp, int spt, int dp, int dpt) { mm64(RB(sp), RB(spt), wid, lane, [&](int i, int j, float v) { RB(dp)[i * LDW + j] = f2bf(v); RB(dpt)[j * LDW + i] = f2bf(v); }); };
    auto tmu = [&](int st, int spt, int dt) { mm64(RB(st), RB(spt), wid, lane, [&](int i, int j, float v) { RB(dt)[i * LDW + j] = f2bf(v + bf2f(RB(st)[i * LDW + j])); }); };
    sq(9, 10, 0, 1); __syncthreads();
    tmu(8, 1, 2); sq(0, 1, 9, 10); __syncthreads();
    tmu(2, 10, 8); sq(9, 10, 0, 1); __syncthreads();
    tmu(8, 1, 2); sq(0, 1, 9, 10); __syncthreads();
    tmu(2, 10, 8); sq(9, 10, 0, 1); __syncthreads();
    tmu(8, 1, 2); __syncthreads();
    mm64(RB(5), RB(2), wid, lane, [&](int k2, int j, float v) { RB(9)[k2 * LDW + j] = f2bf(v); });
    mm64(RB(12), RB(2), wid, lane, [&](int t, int j, float v) { RB(10)[t * LDW + j] = f2bf(v); });
    __syncthreads();
    { bf16_t* PTu = Gp.PT + (size_t)uidx * 4096;
      mm64(RB(9), RB(4), wid, lane, [&](int k2, int k1, float v) { const float p = v + (k2 == k1 ? GCs[k2] : 0.f);
          const int rtk = k1 >> 4, q = (k1 >> 2) & 3, jj = k1 & 3, s_ = rtk >> 1, j = 4 * (rtk & 1) + jj;
          PTu[(((k2 >> 4) * 2 + s_) * 64 + q * 16 + (k2 & 15)) * 8 + j] = f2bf(p); }); }
    mm64(RB(9), RB(11), wid, lane, [&](int k2, int j, float v) { RB(0)[k2 * LDW + j] = f2bf(v + bf2f(RB(7)[k2 * LDW + j])); });
    { bf16_t* GTu = Gp.GT + (size_t)uidx * 4096;
      mm64(RB(10), RB(4), wid, lane, [&](int t, int k, float v) { GTu[t * 64 + k] = f2bf(v + bf2f(RB(3)[t * LDW + k])); }); }
    mm64(RB(10), RB(11), wid, lane, [&](int t, int j, float v) { RB(1)[t * LDW + j] = f2bf(v + bf2f(RB(13)[t * LDW + j])); });
    __syncthreads();
    { float* QTu = Gp.QT + (size_t)uidx * 4096;
      mm64(RB(0), RB(6), wid, lane, [&](int k2, int vv, float v) { QTu[(((vv >> 4) * 4 + (k2 >> 4)) * 64 + ((k2 >> 2) & 3) * 16 + (vv & 15)) * 4 + (k2 & 3)] = v; }); }
    { bf16_t* YLu = Gp.YL + (size_t)uidx * 4096;
      mm64(RB(1), RB(6), wid, lane, [&](int t, int vv, float v) { YLu[t * 64 + vv] = f2bf(v); }); }
    __syncthreads();
#undef RB
}
__device__ __forceinline__ void rwkv_scan_wave(const RwkvG& Gp, int b, int h, int sl, int lane) {
    bf16x8 sB[2];
#pragma unroll
    for (int s = 0; s < 2; ++s)
#pragma unroll
        for (int j = 0; j < 8; ++j) sB[s][j] = 0;
    const int q = lane >> 4, vv = 16 * sl + (lane & 15);
    bf16x8 pa[4][4][2]; f32x4 qa[4][4];
    const bf16_t* PTb = Gp.PT + (size_t)(b * 128 * 4 + h) * 4096 + lane * 8; const float* QTb = Gp.QT + (size_t)(b * 128 * 4 + h) * 4096 + (sl * 4 * 64 + lane) * 4;
#pragma unroll
    for (int st = 0; st < 4; ++st) { const bf16_t* PTu = PTb + (size_t)st * 16384; const float* QTu = QTb + (size_t)st * 16384;
#pragma unroll
        for (int r2 = 0; r2 < 4; ++r2) { pa[st][r2][0] = *(const bf16x8*)(PTu + (r2 * 2 + 0) * 512); pa[st][r2][1] = *(const bf16x8*)(PTu + (r2 * 2 + 1) * 512); qa[st][r2] = *(const f32x4*)(QTu + r2 * 256); } }
    for (int c0 = 0; c0 < 128; c0 += 4) {
#pragma unroll
        for (int st = 0; st < 4; ++st) {
            const int c = c0 + st; const int uidx = (b * 128 + c) * 4 + h;
            { bf16_t* S0u = Gp.S0 + (size_t)uidx * 4096 + vv * 64;
#pragma unroll
              for (int s = 0; s < 2; ++s)
#pragma unroll
                  for (int jh = 0; jh < 2; ++jh) { u32x2 w; const u32x4 sw = __builtin_bit_cast(u32x4, sB[s]); w[0] = sw[2 * jh]; w[1] = sw[2 * jh + 1]; *(u32x2*)(S0u + 16 * (2 * s + jh) + 4 * q) = w; } }
            f32x4 acc[4];
#pragma unroll
            for (int r2 = 0; r2 < 4; ++r2) { acc[r2] = MFMA16(pa[st][r2][0], sB[0], qa[st][r2]); acc[r2] = MFMA16(pa[st][r2][1], sB[1], acc[r2]); }
#pragma unroll
            for (int s = 0; s < 2; ++s) { u32x4 p; p[0] = pk2(acc[2 * s][0], acc[2 * s][1]); p[1] = pk2(acc[2 * s][2], acc[2 * s][3]); p[2] = pk2(acc[2 * s + 1][0], acc[2 * s + 1][1]); p[3] = pk2(acc[2 * s + 1][2], acc[2 * s + 1][3]); sB[s] = __builtin_bit_cast(bf16x8, p); }
            { const int cn = c + 4 < 128 ? c + 4 : 127; const bf16_t* PTu = PTb + (size_t)cn * 16384; const float* QTu = QTb + (size_t)cn * 16384;
#pragma unroll
              for (int r2 = 0; r2 < 4; ++r2) { pa[st][r2][0] = *(const bf16x8*)(PTu + (r2 * 2 + 0) * 512); pa[st][r2][1] = *(const bf16x8*)(PTu + (r2 * 2 + 1) * 512); qa[st][r2] = *(const f32x4*)(QTu + r2 * 256); } }
        }
    }
}
__device__ __forceinline__ void rwkv_fix_unit(LAS unsigned char* lds, const bf16_t* __restrict__ projn, const RwkvW& W, const RwkvG& Gp, bf16_t* __restrict__ mix, int b, int c, int h) {
    const int tid = ltid(), wid = tid >> 6, lane = tid & 63;
    const size_t tok0 = (size_t)b * SEQ + (size_t)c * 64; const int uidx = (b * 128 + c) * 4 + h;
    LAS bf16_t* Xg = (LAS bf16_t*)lds; LAS bf16_t* Ys = (LAS bf16_t*)(lds + RBUF); LAS float* YF = (LAS float*)(lds + 2 * RBUF);
    { const int row = tid >> 3, cc = (tid & 7) * 8;
      *(LAS u32x4*)(Xg + row * LDW + cc) = *(const u32x4*)(Gp.GT + (size_t)uidx * 4096 + row * 64 + cc);
      *(LAS u32x4*)(Ys + row * LDW + cc) = *(const u32x4*)(Gp.S0 + (size_t)uidx * 4096 + row * 64 + cc); }
    __syncthreads();
    { const bf16_t* YLu = Gp.YL + (size_t)uidx * 4096;
      mm64(Xg, Ys, wid, lane, [&](int t, int vv, float v) { YF[t * 65 + vv] = v + bf2f(YLu[t * 64 + vv]); }); }
    __syncthreads();
    { const int t = tid >> 3, vg = tid & 7, col0 = h * 64 + vg * 8; const bool hasprev = !(c == 0 && t == 0);
      float y[8]; float s = 0.f;
#pragma unroll
      for (int i = 0; i < 8; ++i) { y[i] = YF[t * 65 + vg * 8 + i]; s += y[i]; }
      s += shx(s, 1, lane); s += shx(s, 2, lane); s += shx(s, 4, lane);
      const float mu = s * (1.0f / 64.0f); float qv = 0.f;
#pragma unroll
      for (int i = 0; i < 8; ++i) { const float d = y[i] - mu; qv += d * d; }
      qv += shx(qv, 1, lane); qv += shx(qv, 2, lane); qv += shx(qv, 4, lane);
      const float rs = rsqrtf(qv * (1.0f / 64.0f) + 64e-5f);
      float v[8]; shifted8(projn + (tok0 + t) * PN + C_PB + 512 + col0, hasprev, W.shift_mu + 512 + col0, v);
      const u32x4 gw = *(const u32x4*)(Gp.G + (tok0 + t) * 256 + col0); const float bon = Gp.BON[(tok0 + t) * 4 + h];
      float o[8];
#pragma unroll
      for (int i = 0; i < 8; ++i) { const float g = (i & 1) ? bfhi(gw[i >> 1]) : bflo(gw[i >> 1]); o[i] = ((y[i] - mu) * rs * W.lnx_g[col0 + i] + W.lnx_b[col0 + i] + bon * v[i]) * g; }
      *(bf16x8*)(mix + (tok0 + t) * D + 384 + col0) = pack8f(o); }
    __syncthreads();
}

constexpr int LIST_CAP = 16384;
struct MoeBuf { int* cnt; int* list_tok; float* list_w; };
__device__ __forceinline__ float max3f(float a, float b, float c) { return fmaxf(a, fmaxf(b, c)); }
__device__ __forceinline__ void ln1_route_unit(LAS unsigned char* lds, const bf16_t* __restrict__ Y1, const float* __restrict__ g, const float* __restrict__ bta, bf16_t* __restrict__ H1,
                                               const float* __restrict__ router_w, const float* __restrict__ router_bias, const MoeBuf& mb, int unit, bool load_rw) {
    LAS float* rwT = (LAS float*)lds;
    LAS int* tokE = (LAS int*)(lds + 65536);
    LAS float* tokW = (LAS float*)(lds + 65536 + 512);
    LAS int* ebase = (LAS int*)(lds + 65536 + 1024);
    const int tid = ltid(), wid = tid >> 6, lane = tid & 63;
    if (load_rw) { for (int i = tid; i < 16384; i += NTHR) rwT[(i & 15) * 1024 + (i >> 4)] = router_w[i]; }
    __syncthreads();
    for (int tt = 0; tt < 8; ++tt) {
        const int tl = wid * 8 + tt; const size_t t = (size_t)unit * 64 + tl;
        float v[16];
#pragma unroll
        for (int i = 0; i < 4; ++i) { const u32x2 a = *(const u32x2*)(Y1 + t * D + lane * 4 + 256 * i); v[4 * i] = bflo(a[0]); v[4 * i + 1] = bfhi(a[0]); v[4 * i + 2] = bflo(a[1]); v[4 * i + 3] = bfhi(a[1]); }
        float s = 0.f;
#pragma unroll
        for (int i = 0; i < 16; ++i) s += v[i];
        const float mu = wave_sum(s, lane) * (1.0f / D); float q = 0.f;
#pragma unroll
        for (int i = 0; i < 16; ++i) { const float d = v[i] - mu; q += d * d; }
        const float rs = rsqrtf(wave_sum(q, lane) * (1.0f / D) + 1e-5f);
#pragma unroll
        for (int i = 0; i < 4; ++i) { const int col = lane * 4 + 256 * i; const f32x4 gv = *(const f32x4*)(g + col), bv = *(const f32x4*)(bta + col);
#pragma unroll
            for (int j = 0; j < 4; ++j) v[4 * i + j] = (v[4 * i + j] - mu) * rs * gv[j] + bv[j];
            u32x2 w; w[0] = pk2(v[4 * i], v[4 * i + 1]); w[1] = pk2(v[4 * i + 2], v[4 * i + 3]); *(u32x2*)(H1 + t * D + col) = w; }
        float sc[16], sl[16];
#pragma unroll
        for (int e = 0; e < 16; ++e) { float a = 0.f;
#pragma unroll
            for (int i = 0; i < 4; ++i) { const f32x4 r = *(const LAS f32x4*)(rwT + e * 1024 + lane * 4 + 256 * i); a += v[4 * i] * r[0] + v[4 * i + 1] * r[1] + v[4 * i + 2] * r[2] + v[4 * i + 3] * r[3]; }
            a = wave_sum(a, lane); sc[e] = sigmoidf_(a); sl[e] = sc[e] + router_bias[e]; }
        float gs[4];
#pragma unroll
        for (int gI = 0; gI < 4; ++gI) { const float a = sl[4 * gI], b = sl[4 * gI + 1], c = sl[4 * gI + 2], d = sl[4 * gI + 3]; gs[gI] = fmaxf(max3f(a + b, a + c, a + d), max3f(b + c, b + d, c + d)); }
        int bg = 0; float best = gs[0];
#pragma unroll
        for (int gI = 1; gI < 4; ++gI) if (gs[gI] > best) { best = gs[gI]; bg = gI; }
        float xs[4], xc[4];
#pragma unroll
        for (int i = 0; i < 4; ++i) { xs[i] = bg == 0 ? sl[i] : (bg == 1 ? sl[4 + i] : (bg == 2 ? sl[8 + i] : sl[12 + i])); xc[i] = bg == 0 ? sc[i] : (bg == 1 ? sc[4 + i] : (bg == 2 ? sc[8 + i] : sc[12 + i])); }
        int i1 = 0; float m1 = xs[0];
#pragma unroll
        for (int i = 1; i < 4; ++i) if (xs[i] > m1) { m1 = xs[i]; i1 = i; }
        int i2 = -1; float m2 = -INFINITY;
#pragma unroll
        for (int i = 0; i < 4; ++i) if (i != i1 && xs[i] > m2) { m2 = xs[i]; i2 = i; }
        const float w1 = i1 == 0 ? xc[0] : (i1 == 1 ? xc[1] : (i1 == 2 ? xc[2] : xc[3])), w2 = i2 == 0 ? xc[0] : (i2 == 1 ? xc[1] : (i2 == 2 ? xc[2] : xc[3]));
        const float inv = 1.0f / (w1 + w2);
        if (lane == 0) { tokE[tl * 2] = bg * 4 + i1; tokE[tl * 2 + 1] = bg * 4 + i2; tokW[tl * 2] = w1 * inv; tokW[tl * 2 + 1] = w2 * inv; }
    }
    __syncthreads();
    if (tid < 16) { int n = 0; for (int i = 0; i < 128; ++i) n += (tokE[i] == tid) ? 1 : 0; ebase[tid] = n ? atomicAdd(mb.cnt + tid, n) : 0; }
    __syncthreads();
    if (tid < 128) { const int e = tokE[tid]; int rank = 0; for (int i = 0; i < tid; ++i) rank += (tokE[i] == e) ? 1 : 0; const int p = ebase[e] + rank;
        mb.list_tok[e * LIST_CAP + p] = (unit * 64 + (tid >> 1)) * 2 + (tid & 1); mb.list_w[e * LIST_CAP + p] = tokW[tid]; }
    __syncthreads();
}
constexpr int TILE_TAB_OFF = 131072, TILE_TAB_N = 160;
__device__ __forceinline__ void build_tile_table(LAS unsigned char* lds, const int* cnt, int tid) {
    LAS int* tab = (LAS int*)(lds + TILE_TAB_OFF);
    if (tid < TILE_TAB_N) { int rem = tid, sel = -1;
#pragma unroll
        for (int e = 0; e < 16; ++e) { const int n = __hip_atomic_load(cnt + e, __ATOMIC_RELAXED, __HIP_MEMORY_SCOPE_AGENT); const int te = (n + 255) >> 8; if (sel < 0) { if (rem < te) sel = e | (rem << 4) | (n << 12); else rem -= te; } }
        tab[tid] = sel; }
    __syncthreads();
}
__device__ __forceinline__ int tile_entry(const LAS int* tab, int ti) { return ti < TILE_TAB_N ? __builtin_amdgcn_readfirstlane(tab[ti]) : -1; }
struct SchedMoe1 {
    const char* H1; const char* W1; const int* list_tok; const LAS int* tab; int G, c;
    __device__ __forceinline__ bool next(int i, pg8::Unit& u) const {
        const int L = i * G + c, ti = L >> 1, ct = L & 1; const int v = tile_entry(tab, ti); if (v < 0) return false; const int e = v & 15;
        u.a = H1; u.b = W1 + ((size_t)e * 512 + ct * 256) * 2048; u.row0 = ti * 256; u.col0 = ct * 128; u.kind = e; u.aux = ((v >> 4) & 255) * 256; u.n = v >> 12; return true;
    }
    __device__ __forceinline__ unsigned a_off(const pg8::Unit& u, int r) const { const int p = u.aux + r; const int ent = p < u.n ? list_tok[u.kind * LIST_CAP + p] : 0; return (unsigned)(ent >> 1) * 2048u; }
};
struct EpiMoe1 {
    static constexpr bool PERM = true;
    const float* list_w; bf16_t* ACT;
    __device__ __forceinline__ void operator()(const f32x4 (&acc)[2][2][4][2], const pg8::Unit& u, int wr, int wc, int fr, int fq) const {
#pragma unroll
        for (int ai = 0; ai < 2; ++ai)
#pragma unroll
            for (int m = 0; m < 4; ++m) { const int r = ai * 128 + wr * 64 + m * 16 + fr, p = u.aux + r; const float w = p < u.n ? list_w[u.kind * LIST_CAP + p] : 0.f;
                float o[8];
#pragma unroll
                for (int n = 0; n < 2; ++n)
#pragma unroll
                    for (int j = 0; j < 4; ++j) { const float gq = acc[ai][0][m][n][j], uq = acc[ai][1][m][n][j]; o[4 * n + j] = gq / (1.0f + __expf(-gq)) * uq * w; }
                *(bf16x8*)(ACT + (size_t)(u.row0 + r) * 256 + u.col0 + wc * 32 + 8 * fq) = pack8f(o); }
    }
};
struct SchedMoe2 {
    const char* ACT; const char* WD; const LAS int* tab; int G, c;
    __device__ __forceinline__ bool next(int i, pg8::Unit& u) const {
        const int L = i * G + c, ti = L >> 2, ct = L & 3; const int v = tile_entry(tab, ti); if (v < 0) return false; const int e = v & 15;
        u.a = ACT + (size_t)ti * 256 * 512; u.b = WD + ((size_t)e * 1024 + ct * 256) * 512; u.row0 = ((v >> 4) & 255) * 256; u.col0 = ct * 256; u.kind = e; u.aux = 0; u.n = v >> 12; return true;
    }
};
struct EpiMoe2 {
    static constexpr bool PERM = true;
    __device__ __forceinline__ void operator()(const f32x4 (&acc)[2][2][4][2], const pg8::Unit& u, int wr, int wc, int fr, int fq) const {
        const KP kp = kparams_l(); char* F = (char*)kp->F; const int* lt = kp->list_tok + u.kind * LIST_CAP;
        const unsigned colb = (unsigned)(u.col0 + wc * 32 + 8 * fq) * 2u; const int pbase = u.row0 + wr * 64 + fr;
#pragma unroll
        for (int ai = 0; ai < 2; ++ai)
#pragma unroll
            for (int m = 0; m < 4; ++m) { const int p = pbase + ai * 128 + m * 16;
                if (p < u.n) { const int ent = lt[p]; char* rowp = F + ((unsigned)((ent & 1) * NTOK + (ent >> 1)) * 2048u + colb);
#pragma unroll
                    for (int bj = 0; bj < 2; ++bj) { const f32x4 v0 = acc[ai][bj][m][0], v1 = acc[ai][bj][m][1]; u32x4 w;
                        w[0] = pk2(v0[0], v0[1]); w[1] = pk2(v0[2], v0[3]); w[2] = pk2(v1[0], v1[1]); w[3] = pk2(v1[2], v1[3]); *(u32x4*)(rowp + bj * 256) = w; } }
                asm volatile("" ::: "memory"); }
    }
};


#define XB_TMO      128
#define XB_XCNT(j)  (256  + 64 * (j))
#define XB_XSUB(j)  (1280 + 64 * (j))
#define XB_XGEN(j)  (2304 + 64 * (j))
#define XB_TOP      3328
#define XB_TOPGEN   3392
#define XCD_BAR_WORDS 3456
#define XB_SPIN_CAP (1u << 18)

__device__ __forceinline__ unsigned xb_ld(unsigned* p)              { return __hip_atomic_load(p, __ATOMIC_RELAXED, __HIP_MEMORY_SCOPE_AGENT); }
__device__ __forceinline__ unsigned xb_add(unsigned* p, unsigned v) { return __hip_atomic_fetch_add(p, v, __ATOMIC_RELAXED, __HIP_MEMORY_SCOPE_AGENT); }
__device__ __forceinline__ unsigned xb_xcc_id() { return (unsigned)__builtin_amdgcn_s_getreg((3 << 11) | 20) & 0xFu; }
#define XB_SPIN(cond, bar) do { unsigned _sp = 0; while (cond) { __builtin_amdgcn_s_sleep(1); \
    if ((++_sp & 255u) == 0u) { if (xb_ld(&(bar)[XB_TMO])) break; if (_sp > XB_SPIN_CAP) { atomicAdd(&(bar)[XB_TMO], 1u); break; } } } } while (0)

struct XcdBarrier {
    unsigned* bar; unsigned x;
    volatile LAS unsigned* st;
};

__device__ __forceinline__ XcdBarrier xcd_barrier_post(unsigned* bar, volatile LAS unsigned* st) {
    XcdBarrier b; b.bar = bar; b.x = xb_xcc_id(); b.st = st;
    if (ltid() == 0) (void)xb_add(&bar[XB_XCNT(b.x)], 1u);
    return b;
}
__device__ __forceinline__ void xcd_barrier_complete(unsigned* bar, unsigned x, unsigned& nloc, unsigned& nx) {
    const unsigned G = gridDim.x * gridDim.y * gridDim.z;
    unsigned sum, cnt, mine, sp = 0u;
    for (;;) {
        sum = 0u; cnt = 0u; mine = 0u;
#pragma unroll
        for (unsigned j = 0; j < 16; ++j) { const unsigned c = xb_ld(&bar[XB_XCNT(j)]); sum += c; cnt += (c > 0u) ? 1u : 0u; mine = (j == x) ? c : mine; }
        if (sum == G) break;
        __builtin_amdgcn_s_sleep(1);
        if ((++sp & 255u) == 0u) { if (xb_ld(&bar[XB_TMO])) break; if (sp > XB_SPIN_CAP) { atomicAdd(&bar[XB_TMO], 1u); break; } }
    }
    nloc = mine > 0u ? mine : 1u; nx = cnt > 0u ? cnt : 1u;
}

__device__ __forceinline__ void xcd_barrier(const XcdBarrier& b) {
    asm volatile("s_waitcnt vmcnt(0)" ::: "memory");
    __syncthreads();
    if (ltid() == 0) {
        unsigned* bar = b.bar;
        __builtin_amdgcn_s_waitcnt(0);
        unsigned nloc = b.st[0], nx = b.st[1];
        if (nloc == 0u) { xcd_barrier_complete(bar, b.x, nloc, nx); b.st[0] = nloc; b.st[1] = nx; }
        const unsigned old = xb_add(&bar[XB_XSUB(b.x)], 1u);
        const unsigned gen = old / nloc;
        if (old + 1u == (gen + 1u) * nloc) {
            __builtin_amdgcn_fence(__ATOMIC_RELEASE, "agent");
            asm volatile("s_waitcnt vmcnt(0)" ::: "memory");
            const unsigned og = xb_add(&bar[XB_TOP], 1u);
            const unsigned tg = og / nx;
            if (og + 1u == (tg + 1u) * nx) xb_add(&bar[XB_TOPGEN], 1u);
            else XB_SPIN(xb_ld(&bar[XB_TOPGEN]) == tg, bar);
            __builtin_amdgcn_fence(__ATOMIC_ACQUIRE, "agent");
            xb_add(&bar[XB_XGEN(b.x)], 1u);
            asm volatile("s_waitcnt vmcnt(0)" ::: "memory");
        } else {
            XB_SPIN(xb_ld(&bar[XB_XGEN(b.x)]) == gen, bar);
            __builtin_amdgcn_fence(__ATOMIC_ACQUIRE, "agent");
            asm volatile("s_waitcnt vmcnt(0)" ::: "memory");
        }
    }
    __syncthreads();
}


constexpr int LDS_BAR_OFF = 133632;
constexpr int LDS_TOTAL = LDS_BAR_OFF + 16;
static_assert(RW_LDS <= LDS_BAR_OFF && pg8::STAGE_BYTES <= LDS_BAR_OFF, "LDS map");
constexpr int CONV_A = 976, CONV_B = 3072;
__device__ __forceinline__ int conv_a_unit(int i) { return i < 960 ? i : i - 960 + 4032; }
__device__ __forceinline__ int conv_b_unit(int i) { return i + 960; }

#define PHASE_FN __device__ __forceinline__ void
#define PHASE_PROLOGUE extern __shared__ __attribute__((aligned(16))) unsigned char shm[]; LAS unsigned char* lds = (LAS unsigned char*)shm; const KP p = kparams_l(); \
    const int tid = ltid(); const int c = lbid(); const int G = (int)gridDim.x, wid = tid >> 6, lane = tid & 63; (void)lds; (void)c; (void)G; (void)wid; (void)lane;
__device__ __forceinline__ ConvP conv_params(KP p, int l) {
    ConvP c; c.w_in = p->w_in + (size_t)l * D * INC; c.w_out = p->w_out + (size_t)l * D * D; c.w_gate = p->w_gate + (size_t)l * 16 * 1024 * 256; c.w_up = p->w_up + (size_t)l * 16 * 1024 * 256;
    c.w_down = p->w_down + (size_t)l * 16 * 256 * 1024; c.decay_up = p->decay_up + (size_t)l * 64 * 256; c.iclr_up = p->iclr_up + (size_t)l * 64 * 256; c.gate_up = p->gate_up + (size_t)l * 128 * 256;
    c.WIN_T = p->WIN_T; c.WOUT_T = p->WOUT_T; c.W1_T = p->W1_T; c.WD_T = p->WD_T; c.DUP_T = p->DUP_T; c.IUP_T = p->IUP_T; c.GUP_T = p->GUP_T; return c;
}
__device__ __forceinline__ RwkvW rwkv_w(KP p, int l) { return RwkvW{p->shift_mu + l * 1024, p->decay_w0 + l * 256, p->iclr_a0 + l * 256, p->k_k + l * 256, p->k_a + l * 256, p->r_k + l * 256, p->lnx_g + l * 256, p->lnx_b + l * 256, p->DUP_T, p->IUP_T, p->GUP_T}; }
__device__ __forceinline__ RwkvG rwkv_g(KP p) { char* r = p->RWG; return RwkvG{(bf16_t*)(r + RWG_PT), (float*)(r + RWG_QT), (bf16_t*)(r + RWG_GT), (bf16_t*)(r + RWG_YL), (bf16_t*)(r + RWG_S0), (bf16_t*)(r + RWG_G), (float*)(r + RWG_BON)}; }

PHASE_FN ph_barrier() {
    extern __shared__ __attribute__((aligned(16))) unsigned char shm[];
    XcdBarrier b; b.bar = kparams_l()->bar; b.x = xb_xcc_id(); b.st = (volatile LAS unsigned*)((LAS unsigned char*)shm + LDS_BAR_OFF);
    xcd_barrier(b);
}
PHASE_FN ph_ln0_conv() {
    PHASE_PROLOGUE
    for (int t = c * 8 + wid; t < NTOK; t += G * 8) {
        float v[16];
#pragma unroll
        for (int i = 0; i < 4; ++i) { const f32x4 a = *(const f32x4*)(p->x + (size_t)t * D + lane * 4 + 256 * i); v[4 * i] = a[0]; v[4 * i + 1] = a[1]; v[4 * i + 2] = a[2]; v[4 * i + 3] = a[3]; }
        ln_finish_store(v, p->ln0_g, p->ln0_b, lane, p->H + (size_t)t * D, nullptr);
    }
    const ConvP cp = conv_params(p, 0); for (int i = c; i < CONV_A; i += G) conv_unit(cp, conv_a_unit(i), (float*)shm);
}
PHASE_FN ph_proj() { PHASE_PROLOGUE phase_proj(lds, p->H, p->WIN_T, p->PROJN, p->VT, G, c); }
PHASE_FN ph_rwkv_prep(int l) { PHASE_PROLOGUE const RwkvW Wr = rwkv_w(p, l); const RwkvG Gp = rwkv_g(p); for (int u = c; u < 1024; u += G) rwkv_prep_unit(lds, p->PROJN, Wr, Gp, u >> 9, (u >> 2) & 127, u & 3); }
PHASE_FN ph_scan() { PHASE_PROLOGUE const RwkvG Gp = rwkv_g(p); if (wid < 4) rwkv_scan_wave(Gp, c >> 2, c & 3, wid, lane); }
PHASE_FN ph_conv_attn(int l) {
    PHASE_PROLOGUE
    if (c == 8 && tid < 16) __hip_atomic_store(p->cnt + tid, 0, __ATOMIC_RELAXED, __HIP_MEMORY_SCOPE_AGENT);
    { const ConvP cp = conv_params(p, l); for (int i = c - 8; i < CONV_B; i += G - 8) conv_unit(cp, conv_b_unit(i), (float*)shm); }
    phase_attn(lds, p->PROJN, p->VT, p->sinks + l * 6, p->rel_bias, p->MIX, (c - 8) * 8 + wid, (G - 8) * 8);
}
PHASE_FN ph_rwkv_fix(int l) { PHASE_PROLOGUE const RwkvW Wr = rwkv_w(p, l); const RwkvG Gp = rwkv_g(p); for (int u = c; u < 1024; u += G) rwkv_fix_unit(lds, p->PROJN, Wr, Gp, p->MIX, u >> 9, (u >> 2) & 127, u & 3); }
PHASE_FN ph_wout() { PHASE_PROLOGUE SchedWout S{(const char*)p->MIX, (const char*)p->WOUT_T, G, c}; EpiWout E{p->H, p->Y1}; pg8::gemm_phase<EpiWout, SchedWout>(lds, 1024, S, E); }
PHASE_FN ph_ln1_route(int l) {
    PHASE_PROLOGUE
    MoeBuf mb{p->cnt, p->list_tok, p->list_w}; bool first = true;
    for (int u = c; u < 256; u += G) { ln1_route_unit(lds, p->Y1, p->ln1_g + l * D, p->ln1_b + l * D, p->H1, p->router_w, p->router_bias, mb, u, first); first = false; }
}
PHASE_FN ph_moe1() {
    PHASE_PROLOGUE
    build_tile_table(lds, p->cnt, tid);
    SchedMoe1 S{(const char*)p->H1, (const char*)p->W1_T, p->list_tok, (const LAS int*)(lds + TILE_TAB_OFF), G, c};
    EpiMoe1 E{p->list_w, p->ACT}; pg8::gemm_phase<EpiMoe1, SchedMoe1, true>(lds, 1024, S, E);
}
PHASE_FN ph_moe2() {
    PHASE_PROLOGUE
    build_tile_table(lds, p->cnt, tid);
    SchedMoe2 S{(const char*)p->ACT, (const char*)p->WD_T, (const LAS int*)(lds + TILE_TAB_OFF), G, c};
    int K2 = 256; asm volatile("" : "+s"(K2));
    EpiMoe2 E; pg8::gemm_phase<EpiMoe2, SchedMoe2, false>(lds, K2, S, E);
}
PHASE_FN ph_ln2(int l) {
    PHASE_PROLOGUE
    for (int t = c * 8 + wid; t < NTOK; t += G * 8) {
        float v[16];
#pragma unroll
        for (int i = 0; i < 4; ++i) { const size_t o = (size_t)t * D + lane * 4 + 256 * i; const u32x2 a = *(const u32x2*)(p->H1 + o), f0 = *(const u32x2*)(p->F + o), f1 = *(const u32x2*)(p->F + (size_t)NTOK * D + o);
            v[4 * i] = ALPHA * bflo(a[0]) + bflo(f0[0]) + bflo(f1[0]); v[4 * i + 1] = ALPHA * bfhi(a[0]) + bfhi(f0[0]) + bfhi(f1[0]);
            v[4 * i + 2] = ALPHA * bflo(a[1]) + bflo(f0[1]) + bflo(f1[1]); v[4 * i + 3] = ALPHA * bfhi(a[1]) + bfhi(f0[1]) + bfhi(f1[1]); }
        ln_finish_store(v, p->ln2_g + l * D, p->ln2_b + l * D, lane, l == 0 ? p->H + (size_t)t * D : nullptr, l == 1 ? p->out + (size_t)t * D : nullptr);
    }
    if (l == 0) { const ConvP cp = conv_params(p, 1); for (int i = c; i < CONV_A; i += G) conv_unit(cp, conv_a_unit(i), (float*)shm); }
}

__global__ void __launch_bounds__(NTHR, 2) k_mega(MegaP pp) {
    (void)pp;
    extern __shared__ __attribute__((aligned(16))) unsigned char shm[];
    { LAS unsigned* st = (LAS unsigned*)((LAS unsigned char*)shm + LDS_BAR_OFF);
      if (ltid() == 0) { st[0] = 0u; st[1] = 0u; st[2] = 0u; st[3] = 0u; }
      __syncthreads();
      (void)xcd_barrier_post(kparams_l()->bar, (volatile LAS unsigned*)st); }
    ph_ln0_conv();
    ph_barrier();
    for (int l = 0; l < 2; ++l) {
        ph_proj(); ph_barrier();
        ph_rwkv_prep(l); ph_barrier();
        { int cb = lbid(); asm volatile("" : "+s"(cb)); if (cb < 8) ph_scan(); else ph_conv_attn(l); }
        ph_barrier();
        ph_rwkv_fix(l); ph_barrier();
        ph_wout(); ph_barrier();
        ph_ln1_route(l); ph_barrier();
        ph_moe1(); ph_barrier();
        ph_moe2(); ph_barrier();
        ph_ln2(l);
        if (l == 0) ph_barrier();
    }
}

extern "C" void kernel_launch(void* const* d_in, const int* in_sizes, int n_in, void* d_out, int out_size, void* d_ws, size_t ws_size, hipStream_t stream) {
    const size_t MiB = 1048576;
    char* ws = (char*)d_ws;
    MegaP p{};
    const float** pin = (const float**)&p;
    for (int i = 0; i < 27; ++i) pin[i] = (const float*)d_in[i];
    p.out = (float*)d_out;
    p.H = (bf16_t*)(ws); p.PROJN = (bf16_t*)(ws + 32 * MiB); p.VT = (bf16_t*)(ws + 104 * MiB); p.MIX = (bf16_t*)(ws + 120 * MiB);
    p.Y1 = (bf16_t*)(ws + 32 * MiB); p.H1 = (bf16_t*)(ws + 64 * MiB); p.ACT = (bf16_t*)(ws + 96 * MiB); p.F = (bf16_t*)(ws + 120 * MiB);
    p.RWG = ws + 152 * MiB;
    bf16_t* Wb = (bf16_t*)(ws + 220 * MiB);
    p.WIN_T = Wb; p.WOUT_T = Wb + (size_t)2816 * 1024; p.W1_T = p.WOUT_T + (size_t)1024 * 1024; p.WD_T = p.W1_T + (size_t)16 * 512 * 1024;
    p.DUP_T = p.WD_T + (size_t)16 * 1024 * 256; p.IUP_T = p.DUP_T + 256 * 64; p.GUP_T = p.IUP_T + 256 * 64;
    char* MISC = ws + 252 * MiB;
    p.cnt = (int*)MISC; p.list_tok = (int*)(MISC + 4096); p.list_w = (float*)(MISC + 4096 + (size_t)16 * LIST_CAP * 4);
    p.bar = (unsigned*)(MISC + 4096 + (size_t)32 * LIST_CAP * 4);
    static int grid = 0;
    if (grid == 0) {
        int dev = 0, cus = 0;
        if (hipGetDevice(&dev) != hipSuccess || hipDeviceGetAttribute(&cus, hipDeviceAttributeMultiprocessorCount, dev) != hipSuccess) { grid = -1; return; }
        if (hipFuncSetAttribute((const void*)k_mega, hipFuncAttributeMaxDynamicSharedMemorySize, LDS_TOTAL) != hipSuccess) { grid = -1; return; }
        grid = cus;
    }
    if (grid < 0) return;
    (void)hipMemsetAsync(p.bar, 0, XCD_BAR_WORDS * sizeof(unsigned), stream);
    hipLaunchKernelGGL(k_mega, dim3(grid), dim3(NTHR), LDS_TOTAL, stream, p);
}
```
